# Optimizing an MI355X kernel written in HIP

```python
import math
import jax, jax.numpy as jnp
from jax import lax
import numpy as np

D_MODEL = 1024
BATCH = 4
SEQ = 8192
DEPTH = 4

GRID_W = 64
HEAD_DIM = D_MODEL // 16
Q_BLOCK = 128
RMS_EPS = 1e-6
NEG_INF = -1e30

NA_HEADS = 4
NA_WIN_H = 8
NA_WIN_W = 16
DIFF_HEADS = 4
DIFF_QK_DIM = HEAD_DIM // 2
DIFF_V_DIM = HEAD_DIM
GQA_Q_HEADS = 4
GQA_KV_HEADS = 2
AXIAL_THETA = 10000.0
DIL_HEADS = 4
DIL_PAIRS = ((128, 1), (512, 4), (2048, 16))
ROPE_THETA = 500000.0
ROPE_FRACTION = 4
D_FF = ((8 * D_MODEL // 3 + 255) // 256) * 256

NA_W = NA_HEADS * HEAD_DIM
DIFF_QK_W = DIFF_HEADS * 2 * DIFF_QK_DIM
DIFF_V_W = DIFF_HEADS * DIFF_V_DIM
GQA_Q_W = GQA_Q_HEADS * HEAD_DIM
GQA_KV_W = GQA_KV_HEADS * HEAD_DIM
DIL_W = DIL_HEADS * HEAD_DIM
IN_SIZES = (NA_W, NA_W, NA_W, DIFF_QK_W, DIFF_QK_W, DIFF_V_W, GQA_Q_W, GQA_KV_W, GQA_KV_W, DIL_W, DIL_W, DIL_W)
IN_WIDTH = sum(IN_SIZES)
MIX_WIDTH = NA_W + DIFF_V_W + GQA_Q_W + DIL_W

kernel_name = 'hybrid_parallel_head_encoder'


def rms_norm(x, gain):
    xf = x.astype(jnp.float32)
    y = xf * lax.rsqrt(jnp.mean(xf * xf, axis=-1, keepdims=True) + RMS_EPS)
    return (y * gain.astype(jnp.float32)).astype(x.dtype)


def rope_tables(pos, dim, theta):
    inv_freq = 1.0 / (theta ** (jnp.arange(0, dim, 2, dtype=jnp.float32) / dim))
    ang = pos.astype(jnp.float32)[:, None] * inv_freq[None, :]
    return jnp.cos(ang), jnp.sin(ang)


def apply_rope(x, cos, sin):
    x1, x2 = jnp.split(x.astype(jnp.float32), 2, axis=-1)
    c = cos[None, :, None, :]
    s = sin[None, :, None, :]
    return jnp.concatenate([x1 * c - x2 * s, x1 * s + x2 * c], axis=-1).astype(x.dtype)


def partial_rope(x, cos, sin, n_rot):
    return jnp.concatenate([apply_rope(x[..., :n_rot], cos, sin), x[..., n_rot:]], axis=-1)


def swiglu(h, w_gate, w_up, w_down):
    return (jax.nn.silu(h @ w_gate) * (h @ w_up)) @ w_down


def split_in_proj(h):
    points = np.cumsum(IN_SIZES)[:-1].tolist()
    return jnp.split(h, points, axis=-1)


def neighborhood_attention(q, k, v, q_gain, k_gain, rel_bias, rows):
    B, S, _ = q.shape
    H, d = NA_HEADS, HEAD_DIM
    q = rms_norm(q.reshape(B, S, H, d), q_gain)
    k = rms_norm(k.reshape(B, S, H, d), k_gain)
    v = v.reshape(B, S, H, d)
    to_grid = lambda t: t.reshape(B, rows, GRID_W, H, d).transpose(0, 3, 1, 2, 4)
    qg, kg, vg = to_grid(q), to_grid(k), to_grid(v)
    kh = min(NA_WIN_H, rows)
    cols = jnp.arange(GRID_W)
    col_idx = jnp.clip(cols - NA_WIN_W // 2, 0, GRID_W - NA_WIN_W)[:, None] + jnp.arange(NA_WIN_W)[None, :]
    col_off = col_idx - cols[:, None] + (NA_WIN_W - 1)
    scale = d ** -0.5

    def row_fn(r):
        rs = jnp.clip(r - kh // 2, 0, rows - kh)
        q_r = lax.dynamic_index_in_dim(qg, r, axis=2, keepdims=False)
        k_rows = lax.dynamic_slice_in_dim(kg, rs, kh, axis=2)
        v_rows = lax.dynamic_slice_in_dim(vg, rs, kh, axis=2)
        k_win = k_rows[:, :, :, col_idx]
        v_win = v_rows[:, :, :, col_idx]
        row_off = rs + jnp.arange(kh) - r + (NA_WIN_H - 1)
        bias = rel_bias[:, row_off][:, :, col_off].transpose(0, 2, 1, 3)
        s = jnp.einsum('bhcd,bhacjd->bhcaj', q_r, k_win).astype(jnp.float32) * scale
        s = s + bias[None].astype(jnp.float32)
        p = jax.nn.softmax(s.reshape(B, H, GRID_W, kh * NA_WIN_W), axis=-1).reshape(s.shape)
        return jnp.einsum('bhcaj,bhacjd->bhcd', p.astype(v.dtype), v_win)

    out = lax.map(row_fn, jnp.arange(rows))
    return out.transpose(1, 0, 3, 2, 4).reshape(B, S, H * d)


def diff_attention(q, k, v, q_gain, k_gain, lq1, lk1, lq2, lk2, out_gain, lambda_init, cos, sin):
    B, S, _ = q.shape
    H, d = DIFF_HEADS, DIFF_QK_DIM
    n_rot = d // ROPE_FRACTION

    def prep(t, g):
        t = partial_rope(rms_norm(t.reshape(B, S, 2 * H, d), g), cos, sin, n_rot)
        return t.reshape(B, S, H, 2, d).transpose(3, 0, 2, 1, 4)

    q12 = prep(q, q_gain)
    k12 = prep(k, k_gain)
    vt = v.reshape(B, S, H, DIFF_V_DIM).transpose(0, 2, 1, 3)
    lam = (jnp.exp(jnp.sum(lq1.astype(jnp.float32) * lk1.astype(jnp.float32)))
           - jnp.exp(jnp.sum(lq2.astype(jnp.float32) * lk2.astype(jnp.float32))) + lambda_init)
    scale = d ** -0.5
    nb = S // Q_BLOCK
    qb = q12.reshape(2, B, H, nb, Q_BLOCK, d).transpose(3, 0, 1, 2, 4, 5)

    def block_fn(qblk):
        s = jnp.einsum('ibhqd,ibhkd->ibhqk', qblk, k12).astype(jnp.float32) * scale
        p = jax.nn.softmax(s, axis=-1)
        a = p[0] - lam * p[1]
        return jnp.einsum('bhqk,bhkd->bhqd', a.astype(vt.dtype), vt)

    o = lax.map(block_fn, qb)
    o = o.transpose(1, 2, 0, 3, 4).reshape(B, H, S, DIFF_V_DIM)
    o = rms_norm(o, out_gain) * (1.0 - lambda_init)
    return o.transpose(0, 2, 1, 3).reshape(B, S, H * DIFF_V_DIM)


def gqa_axial_attention(q, k, v, q_gain, k_gain, row_cs, col_cs):
    B, S, _ = q.shape
    Hq, Hkv, d = GQA_Q_HEADS, GQA_KV_HEADS, HEAD_DIM
    G = Hq // Hkv
    half = d // 2

    def axial(t):
        return jnp.concatenate([apply_rope(t[..., :half], *row_cs), apply_rope(t[..., half:], *col_cs)], axis=-1)

    q = axial(rms_norm(q.reshape(B, S, Hq, d), q_gain))
    k = axial(rms_norm(k.reshape(B, S, Hkv, d), k_gain))
    kt = k.transpose(0, 2, 1, 3)
    vt = v.reshape(B, S, Hkv, d).transpose(0, 2, 1, 3)
    nb = S // Q_BLOCK
    qb = q.reshape(B, nb, Q_BLOCK, Hkv, G, d).transpose(1, 0, 3, 4, 2, 5)
    scale = d ** -0.5

    def block_fn(qblk):
        s = jnp.einsum('bngqd,bnkd->bngqk', qblk, kt).astype(jnp.float32) * scale
        p = jax.nn.softmax(s, axis=-1)
        return jnp.einsum('bngqk,bnkd->bngqd', p.astype(vt.dtype), vt)

    o = lax.map(block_fn, qb)
    return o.transpose(1, 0, 4, 2, 3, 5).reshape(B, S, Hq * d)


def dilated_attention(q, k, v, q_gain, k_gain, cos, sin):
    B, S, _ = q.shape
    H, d = DIL_HEADS, HEAD_DIM
    n_rot = d // ROPE_FRACTION
    q = partial_rope(rms_norm(q.reshape(B, S, H, d), q_gain), cos, sin, n_rot).transpose(0, 2, 1, 3)
    k = partial_rope(rms_norm(k.reshape(B, S, H, d), k_gain), cos, sin, n_rot).transpose(0, 2, 1, 3)
    v = v.reshape(B, S, H, d).transpose(0, 2, 1, 3)
    nb = S // Q_BLOCK
    scale = d ** -0.5

    def block_fn(b):
        t = b * Q_BLOCK + jnp.arange(Q_BLOCK)
        q_b = lax.dynamic_slice_in_dim(q, b * Q_BLOCK, Q_BLOCK, axis=2)
        outs, lses = [], []
        for window, dil in DIL_PAIRS:
            n_side = (window // 2) // dil
            idx = t[:, None] + dil * jnp.arange(-n_side, n_side + 1)[None, :]
            valid = (idx >= 0) & (idx < S)
            idx = jnp.clip(idx, 0, S - 1)
            k_g = jnp.take(k, idx, axis=2)
            v_g = jnp.take(v, idx, axis=2)
            s = jnp.einsum('bhqd,bhqnd->bhqn', q_b, k_g).astype(jnp.float32) * scale
            s = jnp.where(valid[None, None], s, NEG_INF)
            lse = jax.nn.logsumexp(s, axis=-1, keepdims=True)
            p = jnp.exp(s - lse)
            outs.append(jnp.einsum('bhqn,bhqnd->bhqd', p.astype(v.dtype), v_g).astype(jnp.float32))
            lses.append(lse)
        w = jax.nn.softmax(jnp.stack(lses, axis=0), axis=0)
        return jnp.sum(w * jnp.stack(outs, axis=0), axis=0).astype(v.dtype)

    o = lax.map(block_fn, jnp.arange(nb))
    return o.transpose(1, 0, 3, 2, 4).reshape(B, S, H * d)


def setup_inputs(seed: int = 0) -> dict:
    key = jax.random.key(seed)
    ks = jax.random.split(key, 32)
    L, D, F = DEPTH, D_MODEL, D_FF

    def w(i, shape, fan_in):
        return jax.random.normal(ks[i], shape, jnp.float32) * (fan_in ** -0.5)

    def gain(i, shape):
        return 1.0 + 0.02 * jax.random.normal(ks[i], shape, jnp.float32)

    def small(i, shape, sd):
        return sd * jax.random.normal(ks[i], shape, jnp.float32)

    return {
        'x': jax.random.normal(ks[0], (BATCH, SEQ, D), jnp.float32),
        'ffn1_norm': gain(1, (L, D)),
        'ffn1_w_gate': w(2, (L, D, F), D),
        'ffn1_w_up': w(3, (L, D, F), D),
        'ffn1_w_down': w(4, (L, F, D), F),
        'mix_norm': gain(5, (L, D)),
        'w_in': w(6, (L, D, IN_WIDTH), D),
        'w_out': w(7, (L, MIX_WIDTH, D), MIX_WIDTH),
        'na_q_norm': gain(8, (L, HEAD_DIM)),
        'na_k_norm': gain(9, (L, HEAD_DIM)),
        'na_rel_bias': small(10, (L, NA_HEADS, 2 * NA_WIN_H - 1, 2 * NA_WIN_W - 1), 0.02),
        'diff_q_norm': gain(11, (L, DIFF_QK_DIM)),
        'diff_k_norm': gain(12, (L, DIFF_QK_DIM)),
        'diff_lambda_q1': small(13, (L, DIFF_QK_DIM), 0.1),
        'diff_lambda_k1': small(14, (L, DIFF_QK_DIM), 0.1),
        'diff_lambda_q2': small(15, (L, DIFF_QK_DIM), 0.1),
        'diff_lambda_k2': small(16, (L, DIFF_QK_DIM), 0.1),
        'diff_out_norm': gain(17, (L, DIFF_V_DIM)),
        'gqa_q_norm': gain(18, (L, HEAD_DIM)),
        'gqa_k_norm': gain(19, (L, HEAD_DIM)),
        'dil_q_norm': gain(20, (L, HEAD_DIM)),
        'dil_k_norm': gain(21, (L, HEAD_DIM)),
        'ffn2_norm': gain(22, (L, D)),
        'ffn2_w_gate': w(23, (L, D, F), D),
        'ffn2_w_up': w(24, (L, D, F), D),
        'ffn2_w_down': w(25, (L, F, D), F),
    }


def reference(x, ffn1_norm, ffn1_w_gate, ffn1_w_up, ffn1_w_down, mix_norm, w_in, w_out,
              na_q_norm, na_k_norm, na_rel_bias, diff_q_norm, diff_k_norm,
              diff_lambda_q1, diff_lambda_k1, diff_lambda_q2, diff_lambda_k2, diff_out_norm,
              gqa_q_norm, gqa_k_norm, dil_q_norm, dil_k_norm,
              ffn2_norm, ffn2_w_gate, ffn2_w_up, ffn2_w_down):
    B, S, _ = x.shape
    rows = S // GRID_W
    pos = jnp.arange(S, dtype=jnp.int32)
    diff_cs = rope_tables(pos, DIFF_QK_DIM // ROPE_FRACTION, ROPE_THETA)
    dil_cs = rope_tables(pos, HEAD_DIM // ROPE_FRACTION, ROPE_THETA)
    row_cs = rope_tables(pos // GRID_W, HEAD_DIM // 2, AXIAL_THETA)
    col_cs = rope_tables(pos % GRID_W, HEAD_DIM // 2, AXIAL_THETA)

    for l in range(DEPTH):
        h = rms_norm(x, ffn1_norm[l])
        x = x + 0.5 * swiglu(h, ffn1_w_gate[l], ffn1_w_up[l], ffn1_w_down[l])

        h = rms_norm(x, mix_norm[l])
        (na_q, na_k, na_v, df_q, df_k, df_v,
         gq_q, gq_k, gq_v, dl_q, dl_k, dl_v) = split_in_proj(h @ w_in[l])
        o_a = neighborhood_attention(na_q, na_k, na_v, na_q_norm[l], na_k_norm[l], na_rel_bias[l], rows)
        lambda_init = 0.8 - 0.6 * math.exp(-0.3 * l)
        o_b = diff_attention(df_q, df_k, df_v, diff_q_norm[l], diff_k_norm[l],
                             diff_lambda_q1[l], diff_lambda_k1[l], diff_lambda_q2[l], diff_lambda_k2[l],
                             diff_out_norm[l], lambda_init, *diff_cs)
        o_c = gqa_axial_attention(gq_q, gq_k, gq_v, gqa_q_norm[l], gqa_k_norm[l], row_cs, col_cs)
        o_d = dilated_attention(dl_q, dl_k, dl_v, dil_q_norm[l], dil_k_norm[l], *dil_cs)
        o = jnp.concatenate([o_a, o_b, o_c, o_d], axis=-1)
        x = x + o @ w_out[l]

        h = rms_norm(x, ffn2_norm[l])
        x = x + 0.5 * swiglu(h, ffn2_w_gate[l], ffn2_w_up[l], ffn2_w_down[l])
    return x
```

```cpp
#include <hip/hip_runtime.h>
#include <hip/hip_cooperative_groups.h>
#include <cstdio>
#include <cstdint>
namespace cg = cooperative_groups;

typedef unsigned short bf16_t;
typedef short bf16x8 __attribute__((ext_vector_type(8)));
typedef short s16x4 __attribute__((ext_vector_type(4)));
typedef float f32x16 __attribute__((ext_vector_type(16)));
typedef float f32x2 __attribute__((ext_vector_type(2)));
typedef float f32x4 __attribute__((ext_vector_type(4)));
typedef __bf16 bf16v2 __attribute__((ext_vector_type(2)));
typedef unsigned u32x4 __attribute__((ext_vector_type(4)));
typedef unsigned u32x2 __attribute__((ext_vector_type(2)));

#define DI __device__ __forceinline__
#define LDS3 __attribute__((address_space(3)))

constexpr int T_TOK = 32768, SEQ = 8192, DM = 1024, DFF = 2816, INW = 2816, NLAYER = 4;
constexpr float LOG2E = 1.4426950408889634f;
constexpr float NEGF = -1e30f;
constexpr int LDSROW = 72;
constexpr int VROW = 96;
constexpr int KVBUF = 64 * LDSROW + 64 * VROW;

constexpr size_t W_GU1 = 0, W_D1 = 5767168, W_IN = 8650752, W_OUT = 11534336, W_GU2 = 12582912, W_D2 = 18350080, W_LAYER = 21233664;
constexpr int TAB_DIFF = 0, TAB_DIL = 65536, TAB_ROW = 196608, TAB_COL = 200704, TAB_LAM = 202752, TAB_BND = 202756, TAB_TOTAL = 202776;

struct Params {
    const float* x;
    const float *ffn1_norm, *ffn1_wg, *ffn1_wu, *ffn1_wd, *mix_norm, *w_in, *w_out;
    const float *na_qn, *na_kn, *na_bias, *df_qn, *df_kn, *lq1, *lk1, *lq2, *lk2, *df_on, *gq_qn, *gq_kn, *dl_qn, *dl_kn;
    const float *ffn2_norm, *ffn2_wg, *ffn2_wu, *ffn2_wd;
    float* out;
    bf16_t* wb;
    bf16_t* h;
    bf16_t* o;
    unsigned char* xl;
    float* ss;
    bf16_t* big;
    float* tabs;
    unsigned* bar;
};

DI float bf2f(unsigned v) { return __uint_as_float(v << 16); }
DI unsigned pack2(float a, float b) {
    bf16v2 r = __builtin_convertvector((f32x2){a, b}, bf16v2);
    return __builtin_bit_cast(unsigned, r);
}
DI f32x16 zero16() { f32x16 z; for (int i = 0; i < 16; ++i) z[i] = 0.f; return z; }
DI int lane_id() { return (int)__builtin_amdgcn_mbcnt_hi(~0u, __builtin_amdgcn_mbcnt_lo(~0u, 0u)); }
DI int otid(int wv) { int l; asm volatile("v_mbcnt_lo_u32_b32 %0, -1, 0\n\tv_mbcnt_hi_u32_b32 %0, -1, %0" : "=v"(l)); return (wv << 6) | l; }
DI float xor32_max(float x) { const auto r = __builtin_amdgcn_permlane32_swap(__float_as_uint(x), __float_as_uint(x), false, false); return fmaxf(__uint_as_float(r[0]), __uint_as_float(r[1])); }
DI float xor32_sum(float x) { const auto r = __builtin_amdgcn_permlane32_swap(__float_as_uint(x), __float_as_uint(x), false, false); return __uint_as_float(r[0]) + __uint_as_float(r[1]); }
DI float fsub_s(float a, float b) { float r; asm("v_sub_f32_e32 %0, %1, %2" : "=v"(r) : "v"(a), "v"(b)); return r; }
#define MFMA32(a, b, c) __builtin_amdgcn_mfma_f32_32x32x16_bf16((a), (b), (c), 0, 0, 0)

__device__ void wprep_tile(const float* __restrict__ src, int c0, int ldn, bf16_t* __restrict__ dst, int K, int n0, int k0,
                           float* tile, const float* __restrict__ gain, int wv) {
    const int tid = otid(wv);
    f32x4 v[8];
#pragma unroll
    for (int i = 0; i < 8; ++i) {
        const int e = tid + 512 * i, k = e >> 4, c4 = e & 15;
        v[i] = *(const f32x4*)(src + (size_t)(k0 + k) * ldn + c0 + 4 * c4);
    }
    __syncthreads();
#pragma unroll
    for (int i = 0; i < 8; ++i) {
        const int e = tid + 512 * i, k = e >> 4, c4 = e & 15;
        const float g = gain ? gain[k0 + k] : 1.0f;
#pragma unroll
        for (int j = 0; j < 4; ++j) tile[(4 * c4 + j) * 257 + k] = v[i][j] * g;
    }
    __syncthreads();
#pragma unroll
    for (int i = 0; i < 4; ++i) {
        const int e = tid + 512 * i, kc = (e & 3) + 4 * (e >> 8), nn = (e >> 2) & 63;
        const float* t = tile + nn * 257 + 8 * kc;
        u32x4 w; w.x = pack2(t[0], t[1]); w.y = pack2(t[2], t[3]); w.z = pack2(t[4], t[5]); w.w = pack2(t[6], t[7]);
        *(u32x4*)(dst + (size_t)(n0 + nn) * K + k0 + 8 * kc) = w;
    }
}

__device__ void phase_wprep(const Params& p, char* smem, int wv) {
    float* tile = (float*)smem;
    constexpr int PER_LAYER = 352 + 176 + 176 + 64 + 352 + 176;
    for (int id = blockIdx.x; id < PER_LAYER * NLAYER; id += gridDim.x) {
        const int l = id / PER_LAYER; int r = id % PER_LAYER;
        bf16_t* wl = p.wb + (size_t)l * W_LAYER;
        if (r < 352) {
            const int j = r >> 2, kt = r & 3, j2 = j >> 2, q = j & 3;
            const float* s = ((q < 2) ? p.ffn1_wg : p.ffn1_wu) + (size_t)l * DM * DFF;
            wprep_tile(s, 128 * j2 + 64 * (q & 1), DFF, wl + W_GU1, DM, 64 * j, 256 * kt, tile, p.ffn1_norm + l * DM, wv);
            continue;
        }
        r -= 352;
        if (r < 176) {
            const int j = r / 11, kt = r % 11;
            wprep_tile(p.ffn1_wd + (size_t)l * DFF * DM, 64 * j, DM, wl + W_D1, DFF, 64 * j, 256 * kt, tile, nullptr, wv);
            continue;
        }
        r -= 176;
        if (r < 176) {
            const int j = r >> 2, kt = r & 3;
            wprep_tile(p.w_in + (size_t)l * DM * INW, 64 * j, INW, wl + W_IN, DM, 64 * j, 256 * kt, tile, p.mix_norm + l * DM, wv);
            continue;
        }
        r -= 176;
        if (r < 64) {
            const int j = r >> 2, kt = r & 3;
            wprep_tile(p.w_out + (size_t)l * DM * DM, 64 * j, DM, wl + W_OUT, DM, 64 * j, 256 * kt, tile, nullptr, wv);
            continue;
        }
        r -= 64;
        if (r < 352) {
            const int j = r >> 2, kt = r & 3, j2 = j >> 2, q = j & 3;
            const float* s = ((q < 2) ? p.ffn2_wg : p.ffn2_wu) + (size_t)l * DM * DFF;
            wprep_tile(s, 128 * j2 + 64 * (q & 1), DFF, wl + W_GU2, DM, 64 * j, 256 * kt, tile, p.ffn2_norm + l * DM, wv);
            continue;
        }
        r -= 352;
        {
            const int j = r / 11, kt = r % 11;
            wprep_tile(p.ffn2_wd + (size_t)l * DFF * DM, 64 * j, DM, wl + W_D2, DFF, 64 * j, 256 * kt, tile, nullptr, wv);
        }
    }
    const int gtid = blockIdx.x * 512 + otid(wv), gstride = gridDim.x * 512;
    float2* tabs2 = (float2*)p.tabs;
    for (int e = gtid; e < 8192 * 4; e += gstride) {
        const int pos = e >> 2, i = e & 3;
        const float inv = 1.0f / powf(500000.0f, (float)(2 * i) / 8.0f);
        const float ang = (float)pos * inv;
        tabs2[TAB_DIFF / 2 + e] = make_float2(cosf(ang), sinf(ang));
    }
    for (int e = gtid; e < 8192 * 8; e += gstride) {
        const int pos = e >> 3, i = e & 7;
        const float inv = 1.0f / powf(500000.0f, (float)(2 * i) / 16.0f);
        const float ang = (float)pos * inv;
        tabs2[TAB_DIL / 2 + e] = make_float2(cosf(ang), sinf(ang));
    }
    for (int e = gtid; e < 128 * 16; e += gstride) {
        const int pos = e >> 4, i = e & 15;
        const float inv = 1.0f / powf(10000.0f, (float)(2 * i) / 32.0f);
        const float ang = (float)pos * inv;
        tabs2[TAB_ROW / 2 + e] = make_float2(cosf(ang), sinf(ang));
    }
    for (int e = gtid; e < 64 * 16; e += gstride) {
        const int pos = e >> 4, i = e & 15;
        const float inv = 1.0f / powf(10000.0f, (float)(2 * i) / 32.0f);
        const float ang = (float)pos * inv;
        tabs2[TAB_COL / 2 + e] = make_float2(cosf(ang), sinf(ang));
    }
    if (gtid < NLAYER) {
        const int l = gtid; float s1 = 0.f, s2 = 0.f;
        for (int i = 0; i < 32; ++i) { s1 += p.lq1[l * 32 + i] * p.lk1[l * 32 + i]; s2 += p.lq2[l * 32 + i] * p.lk2[l * 32 + i]; }
        const float lambda_init = 0.8f - 0.6f * expf(-0.3f * (float)l);
        p.tabs[TAB_LAM + l] = expf(s1) - expf(s2) + lambda_init;
        float gq = 0.f, gk = 0.f, dq = 0.f, dk = 0.f;
        for (int i = 0; i < 64; ++i) { gq = fmaxf(gq, fabsf(p.gq_qn[l * 64 + i])); gk = fmaxf(gk, fabsf(p.gq_kn[l * 64 + i])); }
        for (int i = 0; i < 32; ++i) { dq = fmaxf(dq, fabsf(p.df_qn[l * 32 + i])); dk = fmaxf(dk, fabsf(p.df_kn[l * 32 + i])); }
        float lq = 0.f, lk = 0.f;
        for (int i = 0; i < 64; ++i) { lq = fmaxf(lq, fabsf(p.dl_qn[l * 64 + i])); lk = fmaxf(lk, fabsf(p.dl_kn[l * 64 + i])); }
        p.tabs[TAB_BND + 4 * l] = 8.0f * gq * gk * LOG2E * 1.02f;
        p.tabs[TAB_BND + 4 * l + 1] = 5.656854249f * dq * dk * LOG2E * 1.02f;
        p.tabs[TAB_BND + 4 * l + 3] = 8.0f * lq * lk * LOG2E * 1.02f;
    }
}

__device__ void phase_init_x(const float* __restrict__ src, float* __restrict__ copy_dst, bf16_t* __restrict__ h, float* __restrict__ ss, int wv) {
    const int tid0 = otid(wv); const int lane = tid0 & 63, w = tid0 >> 6;
    for (int row = blockIdx.x * 8 + w; row < T_TOK; row += gridDim.x * 8) {
        float4 v[4]; float acc = 0.f;
#pragma unroll
        for (int i = 0; i < 4; ++i) {
            v[i] = *(const float4*)(src + (size_t)row * DM + (i * 64 + lane) * 4);
            u32x2 pk; pk.x = pack2(v[i].x, v[i].y); pk.y = pack2(v[i].z, v[i].w);
            acc += v[i].x * v[i].x + v[i].y * v[i].y + v[i].z * v[i].z + v[i].w * v[i].w;
            *(u32x2*)(h + (size_t)row * DM + (i * 64 + lane) * 4) = pk;
        }
#pragma unroll
        for (int o = 32; o >= 1; o >>= 1) acc += __shfl_xor(acc, o);
        if (lane < 16) ss[(size_t)row * 16 + lane] = (lane == 0) ? acc : 0.f;
    }
}

namespace pg8 {
#define PG8_LAS __attribute__((address_space(3)))
constexpr int BM = 256, BK = 64, HALF = 128, HTB = HALF * BK * 2  , STAGE_BYTES = 8 * HTB, NXCD = 8, WGM = 8;

__host__ __device__ __forceinline__ int lds_byte(int r, int c) { const int st = (r >> 4) * 2 + (c >> 5), rr = r & 15, cc = c & 31, ob = rr * 64 + cc * 2; return st * 1024 + (ob ^ (((ob >> 9) & 1) << 5)); }
__host__ __device__ __forceinline__ void stage_rc(int b, int& R, int& C) { const int st = b / 1024, sb = b % 1024, swz = sb ^ (((sb >> 9) & 1) << 5); R = (st >> 1) * 16 + swz / 64; C = (st & 1) * 32 + (swz % 64) / 2; }
__host__ __device__ __forceinline__ int perm32(int rho) { const int n = rho >> 4, i = rho & 15; return 8 * (i >> 2) + 4 * n + (i & 3); }

struct Unit { int pm, pn; };
struct Gemm { const bf16_t* A; const bf16_t* Bt; int M, N, K; };

struct StaticOrder {
    int nM, nN, nwg, G, c;
    __host__ __device__ void init(int M, int N, int G_, int c_) { nM = M / BM; nN = N / BM; nwg = nM * nN; G = G_; c = c_; }
    __host__ __device__ bool next(int i, Unit& u) const {
        const int L = i * G + c; if (L >= nwg) return false;
        int wgid = (int)L; { const int q = nwg / NXCD, r = nwg % NXCD, xcd = wgid % NXCD, off = wgid / NXCD; wgid = (xcd < r ? xcd * (q + 1) : r * (q + 1) + (xcd - r) * q) + off; }
        const int nig = WGM * nN, gid = wgid / nig, fm = gid * WGM, gsz = (nM - fm) < WGM ? (nM - fm) : WGM;
        u.pm = fm + ((wgid % nig) % gsz); u.pn = (wgid % nig) / gsz; return true;
    }
    __device__ __forceinline__ void a_ready(const Unit&) const {}
    __device__ __forceinline__ void done(const Unit&) const {}
};

__device__ __forceinline__ float row_rinv(const float* sp) {
    const f32x4 a = *(const f32x4*)sp, b = *(const f32x4*)(sp + 4), c = *(const f32x4*)(sp + 8), d = *(const f32x4*)(sp + 12);
    const float t = (((a[0] + a[1]) + (a[2] + a[3])) + ((b[0] + b[1]) + (b[2] + b[3]))) + (((c[0] + c[1]) + (c[2] + c[3])) + ((d[0] + d[1]) + (d[2] + d[3])));
    return rsqrtf(t * (1.0f / DM) + 1e-6f);
}
struct EpiQkv {
    static constexpr bool PERM = true, AFTER_DRAIN = false;
    static constexpr bool NEEDS_RINV = true;
    bf16_t* O; int ldc; const float* ss; const PG8_LAS float* rinvT;
    __device__ __forceinline__ void operator()(const f32x4 (&acc)[2][2][4][2], const Unit& u, int ui, int wr, int wc, int fr, int fq) const {
        const int row0 = u.pm * BM + wr * 64 + fr, col0 = u.pn * BM + wc * 32 + 8 * fq;
#pragma unroll
        for (int ai = 0; ai < 2; ++ai)
#pragma unroll
            for (int m = 0; m < 4; ++m) { bf16_t* rowp = O + (size_t)(row0 + ai * HALF + m * 16) * ldc + col0;
                const float rinv = rinvT[ui * 256 + wr * 64 + ai * HALF + m * 16 + fr];
#pragma unroll
                for (int bj = 0; bj < 2; ++bj) { const f32x4 v0 = acc[ai][bj][m][0] * rinv, v1 = acc[ai][bj][m][1] * rinv;
                    u32x4 w; w.x = pack2(v0[0], v0[1]); w.y = pack2(v0[2], v0[3]); w.z = pack2(v1[0], v1[1]); w.w = pack2(v1[2], v1[3]);
                    *(u32x4*)(rowp + bj * HALF) = w; } }
    }
};
struct EpiSwiglu {
    static constexpr bool PERM = true, AFTER_DRAIN = false;
    static constexpr bool NEEDS_RINV = true;
    bf16_t* O; int ldc; const float* ss; const PG8_LAS float* rinvT;
    __device__ __forceinline__ void operator()(const f32x4 (&acc)[2][2][4][2], const Unit& u, int ui, int wr, int wc, int fr, int fq) const {
        const int row0 = u.pm * BM + wr * 64 + fr, col0 = u.pn * HALF + wc * 32 + 8 * fq;
#pragma unroll
        for (int ai = 0; ai < 2; ++ai)
#pragma unroll
            for (int m = 0; m < 4; ++m) {
                const float rinv = rinvT[ui * 256 + wr * 64 + ai * HALF + m * 16 + fr];
                const float c1 = rinv * -LOG2E, r2 = rinv * rinv;
                float r[8];
#pragma unroll
                for (int n = 0; n < 2; ++n)
#pragma unroll
                    for (int e = 0; e < 4; ++e) { const float ga = acc[ai][0][m][n][e], ua = acc[ai][1][m][n][e];
                        r[4 * n + e] = (ga * ua) * (r2 * __builtin_amdgcn_rcpf(1.0f + __builtin_amdgcn_exp2f(ga * c1))); }
                u32x4 w; w.x = pack2(r[0], r[1]); w.y = pack2(r[2], r[3]); w.z = pack2(r[4], r[5]); w.w = pack2(r[6], r[7]);
                *(u32x4*)(O + (size_t)(row0 + ai * HALF + m * 16) * ldc + col0) = w; }
    }
};
template <bool IN32, bool OUT32>
struct EpiResid {
    static constexpr bool PERM = true, AFTER_DRAIN = false;
    static constexpr bool NEEDS_RINV = false;
    const float* Xin32; float* Xout32; int ldc; float alpha; bf16_t* H; unsigned char* L; float* ss;
    __device__ __forceinline__ void operator()(const f32x4 (&acc)[2][2][4][2], const Unit& u, int ui, int wr, int wc, int fr, int fq) const {
        const int row0 = u.pm * BM + wr * 64 + fr, col0 = u.pn * BM + wc * 32 + 8 * fq;
#pragma unroll
        for (int ai = 0; ai < 2; ++ai) {
            u32x4 raw[4][2][2];
#pragma unroll
            for (int m = 0; m < 4; ++m) { const size_t off = (size_t)(row0 + ai * HALF + m * 16) * ldc + col0;
#pragma unroll
                for (int bj = 0; bj < 2; ++bj) {
                    if constexpr (IN32) { raw[m][bj][0] = *(const u32x4*)(Xin32 + off + bj * HALF); raw[m][bj][1] = *(const u32x4*)(Xin32 + off + bj * HALF + 4); }
                    else { raw[m][bj][0] = *(const u32x4*)(H + off + bj * HALF); const u32x2 l2 = *(const u32x2*)(L + off + bj * HALF); raw[m][bj][1] = (u32x4){l2.x, l2.y, 0u, 0u}; } } }
#pragma unroll
            for (int m = 0; m < 4; ++m) { const int row = row0 + ai * HALF + m * 16; const size_t off = (size_t)row * ldc + col0;
                float sq = 0.f;
#pragma unroll
                for (int bj = 0; bj < 2; ++bj) {
                    float x[8];
                    if constexpr (IN32) {
#pragma unroll
                        for (int c = 0; c < 4; ++c) { x[c] = __uint_as_float(raw[m][bj][0][c]); x[4 + c] = __uint_as_float(raw[m][bj][1][c]); }
                    } else {
#pragma unroll
                        for (int c2 = 0; c2 < 2; ++c2) {
                            const int lw = (int)raw[m][bj][1][c2];
                            const f32x2 l01 = __builtin_amdgcn_cvt_pk_f32_fp8(lw, false), l23 = __builtin_amdgcn_cvt_pk_f32_fp8(lw, true);
                            const unsigned h0 = raw[m][bj][0][2 * c2], h1 = raw[m][bj][0][2 * c2 + 1];
                            x[4 * c2 + 0] = __uint_as_float(h0 << 16) + l01.x * (1.0f / 256.0f); x[4 * c2 + 1] = __uint_as_float(h0 & 0xffff0000u) + l01.y * (1.0f / 256.0f);
                            x[4 * c2 + 2] = __uint_as_float(h1 << 16) + l23.x * (1.0f / 256.0f); x[4 * c2 + 3] = __uint_as_float(h1 & 0xffff0000u) + l23.y * (1.0f / 256.0f);
                        }
                    }
#pragma unroll
                    for (int c = 0; c < 4; ++c) { x[c] += alpha * acc[ai][bj][m][0][c]; x[4 + c] += alpha * acc[ai][bj][m][1][c]; }
                    if constexpr (OUT32) {
                        *(f32x4*)(Xout32 + off + bj * HALF) = (f32x4){x[0], x[1], x[2], x[3]}; *(f32x4*)(Xout32 + off + bj * HALF + 4) = (f32x4){x[4], x[5], x[6], x[7]};
                    } else {
#pragma unroll
                        for (int c = 0; c < 8; ++c) sq += x[c] * x[c];
                        u32x4 hw4; float r[8];
#pragma unroll
                        for (int c = 0; c < 4; ++c) {
                            const unsigned hw = pack2(x[2 * c], x[2 * c + 1]);
                            hw4[c] = hw; r[2 * c] = __builtin_amdgcn_fmed3f((x[2 * c] - __uint_as_float(hw << 16)) * 256.0f, -440.0f, 440.0f); r[2 * c + 1] = __builtin_amdgcn_fmed3f((x[2 * c + 1] - __uint_as_float(hw & 0xffff0000u)) * 256.0f, -440.0f, 440.0f);
                        }
                        u32x2 lw2;
#pragma unroll
                        for (int c2 = 0; c2 < 2; ++c2) {
                            int w = __builtin_amdgcn_cvt_pk_fp8_f32(r[4 * c2], r[4 * c2 + 1], 0, false);
                            w = __builtin_amdgcn_cvt_pk_fp8_f32(r[4 * c2 + 2], r[4 * c2 + 3], w, true);
                            lw2[c2] = (unsigned)w;
                        }
                        *(u32x4*)(H + off + bj * HALF) = hw4; *(u32x2*)(L + off + bj * HALF) = lw2;
                    }
                }
                if constexpr (!OUT32) { sq += __shfl_xor(sq, 16); sq += __shfl_xor(sq, 32);
                    if (fq == 0) ss[(size_t)row * 16 + u.pn * 4 + wc] = sq; }
            }
        }
    }
};


template <class Epi, class Sched, bool ALIGN_EPI = false, bool SP2 = false>
__device__ __forceinline__ void gemm_phase(PG8_LAS unsigned char* lds, const Gemm g, const Sched& S, const Epi& E, int wv) {
    const int tid = otid(wv), wid = __builtin_amdgcn_readfirstlane(tid >> 6), lane = tid & 63, wr = wid >> 2, wc = wid & 3, fr = lane & 15, fq = lane >> 4;
    const int K = g.K, nt = K / BK;
    unsigned voffA[2], voffB[2];
#pragma unroll
    for (int i = 0; i < 2; ++i) { int R, C; stage_rc(tid * 16 + i * 8192, R, C); const int Rb = Epi::PERM ? ((R & ~31) + perm32(R & 31)) : R;
        voffA[i] = (unsigned)(R * K + C) * 2u; voffB[i] = (unsigned)(Rb * K + C) * 2u; }
    const size_t kstep = (size_t)(BK * 2);
    const size_t hstep = (size_t)HALF * K * 2;
    const size_t tstep = 2 * hstep;
    const unsigned ldsw = (unsigned)wid * 1024u;
    const int aoff = lds_byte(wr * 64 + fr, fq * 8), boff = lds_byte(wc * 32 + fr, fq * 8);
#define PG8_SA(b, h) (((b) * 2 + (h)) * HTB)
#define PG8_SB(b, h) ((4 + (b) * 2 + (h)) * HTB)
#define PG8_STAGE(bufoff, gbase, voff) do { _Pragma("unroll") for (int _i = 0; _i < 2; ++_i) \
        __builtin_amdgcn_global_load_lds((const unsigned*)((const char*)(gbase) + (voff)[_i]), (PG8_LAS unsigned*)(lds + (bufoff) + ldsw + _i * 8192), 16, 0, 0); } while (0)
#define PG8_LDA(dst, b, h) do { _Pragma("unroll") for (int m = 0; m < 4; ++m) _Pragma("unroll") for (int k = 0; k < 2; ++k) dst[m][k] = *(const PG8_LAS bf16x8*)(lds + PG8_SA(b, h) + aoff + m * 2048 + k * 1024); } while (0)
#define PG8_LDB(dst, b, h) do { _Pragma("unroll") for (int n = 0; n < 2; ++n) _Pragma("unroll") for (int k = 0; k < 2; ++k) dst[n][k] = *(const PG8_LAS bf16x8*)(lds + PG8_SB(b, h) + boff + n * 2048 + k * 1024); } while (0)
#define PG8_MMA(ai, bj, At, Bt) do { __builtin_amdgcn_s_setprio(1); _Pragma("unroll") for (int m = 0; m < 4; ++m) _Pragma("unroll") for (int n = 0; n < 2; ++n) _Pragma("unroll") for (int k = 0; k < 2; ++k) \
        acc[ai][bj][m][n] = __builtin_amdgcn_mfma_f32_16x16x32_bf16(Bt[n][k], At[m][k], acc[ai][bj][m][n], 0, 0, 0); __builtin_amdgcn_s_setprio(0); } while (0)
#define PG8_WAIT_V(n) asm volatile("s_waitcnt vmcnt(" #n ")" ::: "memory")
#define PG8_WAIT_L(n) asm volatile("s_waitcnt lgkmcnt(" #n ")" ::: "memory")
#define PG8_BAR __builtin_amdgcn_s_barrier()
#define PG8_SCHED __builtin_amdgcn_sched_barrier(0)
    Unit cur, nxt; int ui = 0;
    if (!S.next(0, cur)) return;
    f32x4 acc[2][2][4][2];
#pragma unroll
    for (int a = 0; a < 2; ++a)
#pragma unroll
        for (int b = 0; b < 2; ++b)
#pragma unroll
            for (int m = 0; m < 4; ++m)
#pragma unroll
                for (int n = 0; n < 2; ++n) acc[a][b][m][n] = (f32x4){0.f, 0.f, 0.f, 0.f};
    bf16x8 At[4][2], B0[2][2], B1[2][2];
    const char* cA = (const char*)g.A + (size_t)cur.pm * tstep; const char* cB = (const char*)g.Bt + (size_t)cur.pn * tstep;
    S.a_ready(cur);
    if constexpr (SP2) {
        PG8_STAGE(PG8_SB(0, 0), cB, voffB); PG8_STAGE(PG8_SB(0, 1), cB + hstep, voffB); PG8_STAGE(PG8_SA(0, 0), cA, voffA); PG8_STAGE(PG8_SA(0, 1), cA + hstep, voffA);
        if (wr == 1) PG8_BAR;
        PG8_WAIT_V(2); PG8_BAR;
        PG8_STAGE(PG8_SB(1, 0), cB + kstep, voffB); PG8_STAGE(PG8_SA(1, 0), cA + kstep, voffA); PG8_STAGE(PG8_SB(1, 1), cB + hstep + kstep, voffB);
        PG8_WAIT_V(6); PG8_BAR;
    } else {
        PG8_STAGE(PG8_SB(0, 0), cB, voffB); PG8_STAGE(PG8_SA(0, 0), cA, voffA); PG8_STAGE(PG8_SB(0, 1), cB + hstep, voffB); PG8_STAGE(PG8_SA(0, 1), cA + hstep, voffA);
        if (wr == 1) PG8_BAR;
        PG8_WAIT_V(4); PG8_BAR;
        PG8_STAGE(PG8_SB(1, 0), cB + kstep, voffB); PG8_STAGE(PG8_SA(1, 0), cA + kstep, voffA); PG8_STAGE(PG8_SB(1, 1), cB + hstep + kstep, voffB);
        PG8_WAIT_V(6); PG8_BAR;
    }
    for (;;) {
        const bool has_next = S.next(ui + 1, nxt);
        const char* nA = has_next ? (const char*)g.A + (size_t)nxt.pm * tstep : cA; const char* nB = has_next ? (const char*)g.Bt + (size_t)nxt.pn * tstep : cB;
        for (int t = 0; t < nt; t += 2) {
            const bool last = (t == nt - 2);
            const char* a1 = cA + (size_t)(t + 1) * kstep;
            const char* a2 = last ? nA : cA + (size_t)(t + 2) * kstep; const char* b2 = last ? nB : cB + (size_t)(t + 2) * kstep;
            const char* a3 = a2 + kstep; const char* b3 = b2 + kstep;
            if (last && has_next) S.a_ready(nxt);
            if constexpr (SP2) {
            PG8_LDB(B0, 0, 0); PG8_LDB(B1, 0, 1); PG8_SCHED; PG8_LDA(At, 0, 0); PG8_STAGE(PG8_SA(1, 1), a1 + hstep, voffA);
            PG8_WAIT_V(8); PG8_WAIT_L(0); PG8_BAR; PG8_MMA(0, 0, At, B0); PG8_MMA(0, 1, At, B1); PG8_BAR; PG8_SCHED;
            PG8_LDA(At, 0, 1); PG8_STAGE(PG8_SB(0, 0), b2, voffB); PG8_STAGE(PG8_SB(0, 1), b2 + hstep, voffB); PG8_STAGE(PG8_SA(0, 0), a2, voffA);
            PG8_WAIT_V(8); PG8_WAIT_L(0); PG8_BAR; PG8_MMA(1, 0, At, B0); PG8_MMA(1, 1, At, B1); PG8_BAR; PG8_SCHED;
            PG8_LDB(B0, 1, 0); PG8_LDB(B1, 1, 1); PG8_SCHED; PG8_LDA(At, 1, 0); PG8_STAGE(PG8_SA(0, 1), a2 + hstep, voffA);
            PG8_WAIT_V(8); PG8_WAIT_L(0); PG8_BAR; PG8_MMA(0, 0, At, B0); PG8_MMA(0, 1, At, B1); PG8_BAR; PG8_SCHED;
            PG8_LDA(At, 1, 1); PG8_STAGE(PG8_SB(1, 0), b3, voffB); PG8_STAGE(PG8_SB(1, 1), b3 + hstep, voffB); PG8_STAGE(PG8_SA(1, 0), a3, voffA);
            PG8_WAIT_V(8); PG8_WAIT_L(0); PG8_BAR; PG8_MMA(1, 0, At, B0); PG8_MMA(1, 1, At, B1); PG8_BAR; PG8_SCHED;
            } else {
            PG8_LDB(B0, 0, 0); PG8_SCHED; PG8_LDA(At, 0, 0); PG8_STAGE(PG8_SA(1, 1), a1 + hstep, voffA);
            PG8_WAIT_L(8); PG8_BAR; PG8_WAIT_L(0); PG8_MMA(0, 0, At, B0); PG8_BAR; PG8_SCHED;
            PG8_LDB(B1, 0, 1); PG8_STAGE(PG8_SB(0, 0), b2, voffB);
            PG8_BAR; PG8_WAIT_L(0); PG8_MMA(0, 1, At, B1); PG8_BAR;
            PG8_LDA(At, 0, 1); PG8_STAGE(PG8_SA(0, 0), a2, voffA);
            PG8_BAR; PG8_WAIT_L(0); PG8_MMA(1, 0, At, B0); PG8_BAR; PG8_SCHED;
            PG8_STAGE(PG8_SB(0, 1), b2 + hstep, voffB);
            PG8_WAIT_V(6); PG8_BAR; PG8_MMA(1, 1, At, B1); PG8_BAR;
            PG8_LDB(B0, 1, 0); PG8_SCHED; PG8_LDA(At, 1, 0); PG8_STAGE(PG8_SA(0, 1), a2 + hstep, voffA);
            PG8_WAIT_L(8); PG8_BAR; PG8_WAIT_L(0); PG8_MMA(0, 0, At, B0); PG8_BAR; PG8_SCHED;
            PG8_LDB(B1, 1, 1); PG8_STAGE(PG8_SB(1, 0), b3, voffB);
            PG8_BAR; PG8_WAIT_L(0); PG8_MMA(0, 1, At, B1); PG8_BAR;
            PG8_LDA(At, 1, 1); PG8_STAGE(PG8_SA(1, 0), a3, voffA);
            PG8_BAR; PG8_WAIT_L(0); PG8_MMA(1, 0, At, B0); PG8_BAR; PG8_SCHED;
            PG8_STAGE(PG8_SB(1, 1), b3 + hstep, voffB);
            PG8_WAIT_V(6); PG8_BAR; PG8_MMA(1, 1, At, B1); PG8_BAR;
            }
        }
        if constexpr (ALIGN_EPI) { if (wr == 0) PG8_BAR; }
        if constexpr (!Epi::AFTER_DRAIN) { E(acc, cur, ui, wr, wc, fr, fq); S.done(cur); }
        if (!has_next) break;
#pragma unroll
        for (int a = 0; a < 2; ++a)
#pragma unroll
            for (int b = 0; b < 2; ++b)
#pragma unroll
                for (int m = 0; m < 4; ++m)
#pragma unroll
                    for (int n = 0; n < 2; ++n) acc[a][b][m][n] = (f32x4){0.f, 0.f, 0.f, 0.f};
        cur = nxt; cA = nA; cB = nB; ++ui;
        if constexpr (ALIGN_EPI) { if (wr == 1) PG8_BAR; }
    }
    PG8_WAIT_V(0);
    if constexpr (!ALIGN_EPI) { if (wr == 0) PG8_BAR; }
    PG8_BAR;
    if constexpr (Epi::AFTER_DRAIN) { E.fused(acc, cur, wr, wc, fr, fq, lds, wid, lane); S.done(cur); }
#undef PG8_SA
#undef PG8_SB
#undef PG8_STAGE
#undef PG8_LDA
#undef PG8_LDB
#undef PG8_MMA
#undef PG8_WAIT_V
#undef PG8_WAIT_L
#undef PG8_BAR
#undef PG8_SCHED
}
}

constexpr int RINV_OFF = 131072, RINV_MAX_UNITS = 11;
template <class Epi>
__device__ __forceinline__ void run_gemm(unsigned char* lds, const bf16_t* A, const bf16_t* Bt, int N, int K, Epi E, int wv) {
    pg8::Gemm g{A, Bt, T_TOK, N, K}; pg8::StaticOrder S; S.init(T_TOK, N, __builtin_amdgcn_readfirstlane((int)gridDim.x), __builtin_amdgcn_readfirstlane((int)blockIdx.x));
    if constexpr (Epi::NEEDS_RINV) {
        float* tab = (float*)(lds + RINV_OFF);
        const int tid = otid(wv);
        pg8::Unit u;
        for (int i = 0; i < RINV_MAX_UNITS && S.next(i, u); ++i)
            if (tid < 256) tab[i * 256 + tid] = pg8::row_rinv(E.ss + (size_t)(u.pm * 256 + tid) * 16);
        __syncthreads();
        E.rinvT = (const PG8_LAS float*)tab;
    }
    pg8::gemm_phase<Epi, pg8::StaticOrder, true, true>((PG8_LAS unsigned char*)lds, g, S, E, wv);
}

template <int W, int ROPE>
DI void prep_unit(bf16_t* ptr, const float* __restrict__ gain, float scale, const float2* __restrict__ t1, const float2* __restrict__ t2) {
    float v[W];
#pragma unroll
    for (int c = 0; c < W / 8; ++c) {
        const u32x4 u = ((const u32x4*)ptr)[c];
        v[8 * c + 0] = bf2f(u.x & 0xffffu); v[8 * c + 1] = bf2f(u.x >> 16);
        v[8 * c + 2] = bf2f(u.y & 0xffffu); v[8 * c + 3] = bf2f(u.y >> 16);
        v[8 * c + 4] = bf2f(u.z & 0xffffu); v[8 * c + 5] = bf2f(u.z >> 16);
        v[8 * c + 6] = bf2f(u.w & 0xffffu); v[8 * c + 7] = bf2f(u.w >> 16);
    }
    float ss = 0.f;
#pragma unroll
    for (int j = 0; j < W; ++j) ss += v[j] * v[j];
    const float rinv = rsqrtf(ss * (1.0f / W) + 1e-6f);
#pragma unroll
    for (int j = 0; j < W; ++j) v[j] = v[j] * rinv * gain[j];
    if (ROPE == 1) {
        constexpr int HF = W / 8;
#pragma unroll
        for (int i = 0; i < HF; ++i) {
            const float2 cs = t1[i]; const float a = v[i], b = v[i + HF];
            v[i] = a * cs.x - b * cs.y; v[i + HF] = a * cs.y + b * cs.x;
        }
    }
    if (ROPE == 2) {
#pragma unroll
        for (int i = 0; i < 16; ++i) {
            float2 cs = t1[i]; float a = v[i], b = v[i + 16];
            v[i] = a * cs.x - b * cs.y; v[i + 16] = a * cs.y + b * cs.x;
            cs = t2[i]; a = v[32 + i]; b = v[48 + i];
            v[32 + i] = a * cs.x - b * cs.y; v[48 + i] = a * cs.y + b * cs.x;
        }
    }
#pragma unroll
    for (int c = 0; c < W / 8; ++c) {
        u32x4 u;
        u.x = pack2(v[8 * c + 0] * scale, v[8 * c + 1] * scale); u.y = pack2(v[8 * c + 2] * scale, v[8 * c + 3] * scale);
        u.z = pack2(v[8 * c + 4] * scale, v[8 * c + 5] * scale); u.w = pack2(v[8 * c + 6] * scale, v[8 * c + 7] * scale);
        ((u32x4*)ptr)[c] = u;
    }
}

__device__ void phase_prep(const Params& p, int l, int wv) {
    const float SC64 = 0.125f * LOG2E, SC32 = 0.17677669529663687f * LOG2E;
    const float2* tabs2 = (const float2*)p.tabs;
    const int tid0 = otid(wv); const int lane = tid0 & 63;
    const int w = wv;
    const int ntask = (T_TOK / 64) * 18;
    for (int task = blockIdx.x * 8 + w; task < ntask; task += gridDim.x * 8) {
        const int tg = task / 18, u = task - tg * 18;
        const int tok = tg * 64 + lane, pos = tok & (SEQ - 1);
        bf16_t* row = p.big + (size_t)tok * INW;
        if (u < 4) prep_unit<64, 0>(row + 256 + u * 64, p.na_kn + l * 64, 1.0f, nullptr, nullptr);
        else if (u < 12) prep_unit<32, 1>(row + 1024 + (u - 4) * 32, p.df_kn + l * 32, 1.0f, tabs2 + TAB_DIFF / 2 + pos * 4, nullptr);
        else if (u < 14) prep_unit<64, 2>(row + 1792 + (u - 12) * 64, p.gq_kn + l * 64, 1.0f, tabs2 + TAB_ROW / 2 + (pos >> 6) * 16, tabs2 + TAB_COL / 2 + (pos & 63) * 16);
        else prep_unit<64, 1>(row + 2304 + (u - 14) * 64, p.dl_kn + l * 64, 1.0f, tabs2 + TAB_DIL / 2 + pos * 8, nullptr);
    }
}

enum { MODE_GQA = 0, MODE_DIFF = 1, MODE_NA = 2, MODE_DIL = 3 };

DI int clampi(int v, int lo, int hi) { return v < lo ? lo : (v > hi ? hi : v); }

template <int MODE, bool FAST>
__device__ void attn_item(const Params& p, int layer, int item, char* smem, int wv) {
    constexpr int NKS = (MODE == MODE_DIFF) ? 2 : 4;
    const int tid = otid(wv), lane = tid & 63, w = tid >> 6, n = lane & 31, h = lane >> 5;
    bf16_t* KV0 = (bf16_t*)smem;
    float* biasS = (float*)(KV0 + 4 * KVBUF);
    int b, qcol0, qcol1, kcol, vcol, ocol0, ocol1, qt0, qt1, ntiles;
    int na_r = 0, na_rsmin = 0, na_rs = 0, na_nrows = 0, dl_c = 0, dl_g = 0;
    if (MODE == MODE_GQA) {
        b = item >> 6; const int kvh = (item >> 5) & 1, qb = item & 31;
        qt0 = qt1 = 256 * qb + 32 * w + n;
        qcol0 = 1536 + (2 * kvh) * 64; qcol1 = qcol0 + 64; kcol = 1792 + kvh * 64; vcol = 1920 + kvh * 64;
        ocol0 = 512 + (2 * kvh) * 64; ocol1 = ocol0 + 64; ntiles = 128;
    } else if (MODE == MODE_DIFF) {
        b = item >> 7; const int hd = (item >> 5) & 3, qb = item & 31;
        qt0 = qt1 = 256 * qb + 32 * w + n;
        qcol0 = qcol1 = 768 + hd * 64; kcol = 1024 + hd * 64; vcol = 1280 + hd * 64; ocol0 = ocol1 = 256 + hd * 64; ntiles = 128;
    } else if (MODE == MODE_NA) {
        b = item >> 6; const int hd = (item >> 4) & 3, rg = item & 15;
        na_r = 8 * rg + w; na_rs = clampi(na_r - 4, 0, 120);
        na_rsmin = clampi(8 * rg - 4, 0, 120);
        const int rsmax = clampi(8 * rg + 7 - 4, 0, 120) + 7;
        na_nrows = rsmax - na_rsmin + 1; ntiles = 8;
        qt0 = 64 * na_r + n; qt1 = qt0 + 32;
        qcol0 = qcol1 = hd * 64; kcol = 256 + hd * 64; vcol = 512 + hd * 64; ocol0 = ocol1 = hd * 64;
        __syncthreads();
        for (int e = tid; e < 15 * 31; e += 512) biasS[64 + e] = p.na_bias[(size_t)(layer * 4 + hd) * 465 + e] * LOG2E;
    } else {
        b = item >> 6; const int hd = (item >> 4) & 3; dl_c = item & 15; dl_g = 0;
        const int rc4 = (w >> 1);
        qt0 = 512 * dl_c + rc4 + 4 * (2 * (w & 1)) + 16 * n; qt1 = qt0 + 4;
        qcol0 = qcol1 = 2048 + hd * 64; kcol = 2304 + hd * 64; vcol = 2560 + hd * 64; ocol0 = ocol1 = 768 + hd * 64; ntiles = 34;
    }
    const bf16_t* qkvb = p.big + (size_t)b * SEQ * INW;

    bf16x8 qf[2][NKS];
    {
        const bf16_t* q0 = qkvb + (size_t)qt0 * INW + qcol0 + 8 * h;
        const bf16_t* q1 = qkvb + (size_t)qt1 * INW + qcol1 + 8 * h;
#pragma unroll
        for (int kk = 0; kk < NKS; ++kk) {
            qf[0][kk] = *(const bf16x8*)(q0 + ((MODE == MODE_DIFF) ? kk : kk) * 16);
            qf[1][kk] = *(const bf16x8*)(q1 + ((MODE == MODE_DIFF) ? 2 + kk : kk) * 16);
        }
    }
    f32x16 O[2][2];
    float mrun[2], lrun[2];
#pragma unroll
    for (int i = 0; i < 2; ++i) { O[i][0] = zero16(); O[i][1] = zero16(); mrun[i] = NEGF; lrun[i] = 0.f; }

    constexpr int NSLOT = (MODE == MODE_DIL) ? 3 : (MODE == MODE_NA) ? 2 : 1;
    auto tile_info = [&](int t, int& base, int& base1, int& base2, int& stride, int& win, bool& u0, bool& u1, int& sl) {
        base1 = 0; base2 = 0; sl = 0;
        if (MODE == MODE_GQA || MODE == MODE_DIFF) { base = 64 * t; stride = 1; win = 0; u0 = u1 = true; }
        else if (MODE == MODE_NA) {
            const int srel = na_rs - na_rsmin; sl = (t >= srel) ? 0 : 1; const int kr = na_rsmin + t + 8 * sl;
            base = 64 * (na_rsmin + t); base1 = base + 512; stride = 1; win = kr; u0 = u1 = true; }
        else {
            if (t < 10) { base = 512 * dl_c - 64 + 64 * t; stride = 1; win = 64; u0 = u1 = true; }
            else if (t < 18) { const int u = t - 10, tt = u & 3, pi = u >> 2, rc4 = w >> 1;
                base = 512 * dl_c - 256 + 2 * pi + 256 * tt; base1 = base + 1; stride = 4; win = 256; u0 = u1 = ((rc4 >> 1) == pi); sl = rc4 & 1; }
            else { const int v = t - 18;
                   const int q0 = v & 15, q1 = (v + 5) & 15, q2 = (v + 10) & 15;
                   auto cls = [](int q) { const int wq = q >> 1, iq = q & 1; return (wq >> 1) + 4 * (2 * (wq & 1) + iq); };
                   base = 512 * dl_c - 1024 + cls(q0); base1 = 512 * dl_c - 1024 + cls(q1) + 1024; base2 = 512 * dl_c - 1024 + cls(q2) + 2048; stride = 16; win = 1024;
                   const int myq = (w == (q0 >> 1)) ? q0 : (w == (q1 >> 1)) ? q1 : (w == (q2 >> 1)) ? q2 : -1;
                   sl = (myq == q1) ? 1 : (myq == q2) ? 2 : 0;
                   u0 = (myq >= 0) && ((myq & 1) == 0); u1 = (myq >= 0) && ((myq & 1) == 1); }
        }
    };

    const int lrow = tid >> 3, lcp = (tid & 7) * 8;
    u32x4 rk, rv, rk1, rv1, rk2, rv2;
    auto gload = [&](int t) {
        int base, base1, base2, stride, win, sl; bool u0, u1; tile_info(t, base, base1, base2, stride, win, u0, u1, sl);
        const int tok = clampi(base + lrow * stride, 0, SEQ - 1);
        const bf16_t* src = qkvb + (size_t)tok * INW + lcp;
        rk = *(const u32x4*)(src + kcol);
        rv = *(const u32x4*)(src + vcol);
        if constexpr (NSLOT >= 2) {
            if ((MODE == MODE_DIL) ? (t >= 10) : (t + 8 < na_nrows)) {
                const int tok1 = clampi(base1 + lrow * stride, 0, SEQ - 1);
                const bf16_t* src1 = qkvb + (size_t)tok1 * INW + lcp;
                rk1 = *(const u32x4*)(src1 + kcol);
                rv1 = *(const u32x4*)(src1 + vcol);
            }
        }
        if constexpr (NSLOT == 3) {
            if (t >= 18) {
                const int tok2 = clampi(base2 + lrow * stride, 0, SEQ - 1);
                const bf16_t* src2 = qkvb + (size_t)tok2 * INW + lcp;
                rk2 = *(const u32x4*)(src2 + kcol);
                rv2 = *(const u32x4*)(src2 + vcol);
            }
        }
    };
    auto lstore = [&](int t) {
        bf16_t* Kn = KV0 + (t & 1) * (NSLOT * KVBUF);
        *(u32x4*)(Kn + lrow * LDSROW + lcp) = rk;
        *(u32x4*)(Kn + 64 * LDSROW + lrow * VROW + lcp) = rv;
        if constexpr (NSLOT >= 2) {
            if ((MODE == MODE_DIL) ? (t >= 10) : (t + 8 < na_nrows)) {
                *(u32x4*)(Kn + KVBUF + lrow * LDSROW + lcp) = rk1;
                *(u32x4*)(Kn + KVBUF + 64 * LDSROW + lrow * VROW + lcp) = rv1;
            }
        }
        if constexpr (NSLOT == 3) {
            if (t >= 18) {
                *(u32x4*)(Kn + 2 * KVBUF + lrow * LDSROW + lcp) = rk2;
                *(u32x4*)(Kn + 2 * KVBUF + 64 * LDSROW + lrow * VROW + lcp) = rv2;
            }
        }
    };
    gload(0);
    {
        constexpr int W = (MODE == MODE_DIFF) ? 32 : 64;
        const float* qg = (MODE == MODE_GQA) ? p.gq_qn + layer * 64 : (MODE == MODE_DIFF) ? p.df_qn + layer * 32 : (MODE == MODE_NA) ? p.na_qn + layer * 64 : p.dl_qn + layer * 64;
        const float qscale = ((MODE == MODE_DIFF) ? 0.17677669529663687f : 0.125f) * LOG2E;
        const float2* tabs2 = (const float2*)p.tabs;
#pragma unroll
        for (int i = 0; i < 2; ++i) {
            const int pos = (i == 0) ? qt0 : qt1;
            float v[NKS][8];
            float ss = 0.f;
#pragma unroll
            for (int kk = 0; kk < NKS; ++kk) {
                const u32x4 u = __builtin_bit_cast(u32x4, qf[i][kk]);
#pragma unroll
                for (int c = 0; c < 4; ++c) { v[kk][2 * c] = bf2f(u[c] & 0xffffu); v[kk][2 * c + 1] = bf2f(u[c] >> 16); }
#pragma unroll
                for (int j = 0; j < 8; ++j) ss += v[kk][j] * v[kk][j];
            }
            ss = xor32_sum(ss);
            const float rinv = rsqrtf(ss * (1.0f / W) + 1e-6f);
#pragma unroll
            for (int kk = 0; kk < NKS; ++kk)
#pragma unroll
                for (int j = 0; j < 8; ++j) v[kk][j] = v[kk][j] * rinv * qg[16 * kk + 8 * h + j];
            if (MODE == MODE_GQA) {
                const float2* tr = tabs2 + TAB_ROW / 2 + (pos >> 6) * 16 + 8 * h;
                const float2* tc = tabs2 + TAB_COL / 2 + (pos & 63) * 16 + 8 * h;
#pragma unroll
                for (int j = 0; j < 8; ++j) {
                    float2 cs = tr[j]; float a = v[0][j], b = v[1][j];
                    v[0][j] = a * cs.x - b * cs.y; v[1][j] = a * cs.y + b * cs.x;
                    cs = tc[j]; a = v[2][j]; b = v[3][j];
                    v[2][j] = a * cs.x - b * cs.y; v[3][j] = a * cs.y + b * cs.x;
                }
            }
            if (MODE == MODE_DIL) {
                const float2* td = tabs2 + TAB_DIL / 2 + pos * 8;
#pragma unroll
                for (int j = 0; j < 8; ++j) {
                    const float mine = v[0][j];
                    const auto r = __builtin_amdgcn_permlane32_swap(__float_as_uint(mine), __float_as_uint(mine), false, false);
                    const float x1 = __uint_as_float(r[0]), x2 = __uint_as_float(r[1]);
                    const float2 cs = td[j];
                    v[0][j] = (h == 0) ? (x1 * cs.x - x2 * cs.y) : (x1 * cs.y + x2 * cs.x);
                }
            }
            if (MODE == MODE_DIFF) {
                const float2* tf = tabs2 + TAB_DIFF / 2 + pos * 4;
#pragma unroll
                for (int j = 0; j < 4; ++j) {
                    const float2 cs = tf[j]; const float a = v[0][j], b = v[0][j + 4];
                    const float ra = a * cs.x - b * cs.y, rb = a * cs.y + b * cs.x;
                    v[0][j] = (h == 0) ? ra : a; v[0][j + 4] = (h == 0) ? rb : b;
                }
            }
#pragma unroll
            for (int kk = 0; kk < NKS; ++kk) {
                u32x4 u;
#pragma unroll
                for (int c = 0; c < 4; ++c) u[c] = pack2(v[kk][2 * c] * qscale, v[kk][2 * c + 1] * qscale);
                qf[i][kk] = __builtin_bit_cast(bf16x8, u);
            }
        }
    }

    __syncthreads();
    lstore(0);
    constexpr bool LAZYLOAD = false;
    if (!LAZYLOAD && ntiles > 1) gload(1);
    __syncthreads();
#pragma unroll 1
    for (int t = 0; t < ntiles; ++t) {
        int base, base1, base2, stride, win, sl; bool use[2];
        tile_info(t, base, base1, base2, stride, win, use[0], use[1], sl);
        if (sl == 1) base = base1; else if (sl == 2) base = base2;
        bf16_t* Ks = KV0 + (t & 1) * (NSLOT * KVBUF) + sl * KVBUF;
        bf16_t* Vs = Ks + 64 * LDSROW;
        if (!LAZYLOAD && t + 1 < ntiles) {
            lstore(t + 1);
            if (t + 2 < ntiles) gload(t + 2);
        }
        if (use[0] || use[1]) {

        bf16x8 pf[2][2][2];
#pragma unroll
        for (int i = 0; i < 2; ++i) {
            if (use[i]) {
                const int tq = (i == 0) ? qt0 : qt1;
                f32x16 Sx[2];
#pragma unroll
                for (int sub = 0; sub < 2; ++sub) {
                    f32x16 sacc = zero16();
#pragma unroll
                    for (int kk = 0; kk < NKS; ++kk) {
                        const bf16x8 kf = *(const bf16x8*)(Ks + (sub * 32 + n) * LDSROW + ((MODE == MODE_DIFF) ? 2 * i + kk : kk) * 16 + 8 * h);
                        sacc = MFMA32(kf, qf[i][kk], sacc);
                    }
                    Sx[sub] = sacc;
                }
                if (MODE == MODE_NA) {
                    const int c = tq & 63, cs = clampi(c - 8, 0, 48), kr = win;
                    const int lo = cs - 4 * h, hi = lo + 15;
                    const float* bp = biasS + 64 + (kr - na_r + 7) * 31 + (4 * h - c + 15);
#pragma unroll
                    for (int sub = 0; sub < 2; ++sub)
#pragma unroll
                        for (int j = 0; j < 16; ++j) {
                            const int cj = sub * 32 + (j & 3) + 8 * (j >> 2);
                            const bool valid = (lo <= cj) && (cj <= hi);
                            const float bv = bp[cj];
                            Sx[sub][j] = valid ? Sx[sub][j] + bv : NEGF;
                        }
                }
                if (MODE == MODE_DIL) {
                    const int sh = (stride == 1) ? 0 : ((stride == 4) ? 2 : 4);
                    const int tlo = (tq - win < 0) ? 0 : tq - win, thi = (tq + win > SEQ - 1) ? SEQ - 1 : tq + win;
                    const int klo = ((tlo - base + stride - 1) >> sh) - 4 * h, khi = ((thi - base) >> sh) - 4 * h;
#pragma unroll
                    for (int sub = 0; sub < 2; ++sub)
#pragma unroll
                        for (int j = 0; j < 16; ++j) {
                            const int cj = sub * 32 + (j & 3) + 8 * (j >> 2);
                            const bool valid = (klo <= cj) && (cj <= khi);
                            Sx[sub][j] = valid ? Sx[sub][j] : NEGF;
                        }
                }
                if constexpr (FAST) {
                    float rs0 = 0.f;
#pragma unroll
                    for (int sub = 0; sub < 2; ++sub)
#pragma unroll
                        for (int j = 0; j < 16; j += 4) {
                            const float p0 = __builtin_amdgcn_exp2f(Sx[sub][j]), p1 = __builtin_amdgcn_exp2f(Sx[sub][j + 1]);
                            const float p2 = __builtin_amdgcn_exp2f(Sx[sub][j + 2]), p3 = __builtin_amdgcn_exp2f(Sx[sub][j + 3]);
                            Sx[sub][j] = p0; Sx[sub][j + 1] = p1; Sx[sub][j + 2] = p2; Sx[sub][j + 3] = p3;
                            rs0 = (((rs0 + p0) + p1) + p2) + p3;
                        }
                    lrun[i] += rs0;
                } else {
                float mx;
                {
                    float m4[4];
#pragma unroll
                    for (int q = 0; q < 4; ++q) {
                        float a = fmaxf(fmaxf(Sx[0][4 * q], Sx[0][4 * q + 1]), Sx[0][4 * q + 2]);
                        a = fmaxf(fmaxf(a, Sx[0][4 * q + 3]), Sx[1][4 * q]);
                        a = fmaxf(fmaxf(a, Sx[1][4 * q + 1]), Sx[1][4 * q + 2]);
                        m4[q] = fmaxf(a, Sx[1][4 * q + 3]);
                    }
                    mx = fmaxf(fmaxf(m4[0], m4[1]), fmaxf(m4[2], m4[3]));
                }
                mx = xor32_max(mx);
                const float mnew = (mx > mrun[i] + 8.0f) ? mx : mrun[i];
                const float alpha = __builtin_amdgcn_exp2f(mrun[i] - mnew);
                mrun[i] = mnew;
                float rs0 = 0.f;
#pragma unroll
                for (int sub = 0; sub < 2; ++sub)
#pragma unroll
                    for (int j = 0; j < 16; j += 4) {
                        const float p0 = __builtin_amdgcn_exp2f(fsub_s(Sx[sub][j], mnew)), p1 = __builtin_amdgcn_exp2f(fsub_s(Sx[sub][j + 1], mnew));
                        const float p2 = __builtin_amdgcn_exp2f(fsub_s(Sx[sub][j + 2], mnew)), p3 = __builtin_amdgcn_exp2f(fsub_s(Sx[sub][j + 3], mnew));
                        Sx[sub][j] = p0; Sx[sub][j + 1] = p1; Sx[sub][j + 2] = p2; Sx[sub][j + 3] = p3;
                        rs0 = (((rs0 + p0) + p1) + p2) + p3;
                    }
                lrun[i] = lrun[i] * alpha + rs0;
                if (__any(alpha != 1.0f)) {
#pragma unroll
                    for (int dt = 0; dt < 2; ++dt)
#pragma unroll
                        for (int j = 0; j < 16; ++j) O[i][dt][j] *= alpha;
                }
                }
#pragma unroll
                for (int sub = 0; sub < 2; ++sub)
#pragma unroll
                    for (int s = 0; s < 2; ++s) {
                        u32x4 u;
                        u.x = pack2(Sx[sub][8 * s + 0], Sx[sub][8 * s + 1]); u.y = pack2(Sx[sub][8 * s + 2], Sx[sub][8 * s + 3]);
                        u.z = pack2(Sx[sub][8 * s + 4], Sx[sub][8 * s + 5]); u.w = pack2(Sx[sub][8 * s + 6], Sx[sub][8 * s + 7]);
                        pf[i][sub][s] = __builtin_bit_cast(bf16x8, u);
                    }
            } else {
#pragma unroll
                for (int sub = 0; sub < 2; ++sub)
#pragma unroll
                    for (int s = 0; s < 2; ++s) pf[i][sub][s] = (bf16x8){0, 0, 0, 0, 0, 0, 0, 0};
            }
        }
        {
            const int blk = (lane >> 4) & 1, q4 = (lane & 15) >> 2, p4 = lane & 3;
            const bf16_t* vbase = Vs + (4 * h + q4) * VROW + 16 * blk + 4 * p4;
#pragma unroll
            for (int sub = 0; sub < 2; ++sub)
#pragma unroll
                for (int s = 0; s < 2; ++s) {
                    bf16x8 vf[2];
#pragma unroll
                    for (int dt = 0; dt < 2; ++dt) {
                        const bf16_t* a = vbase + (sub * 32 + 16 * s) * VROW + dt * 32;
                        const s16x4 lo = __builtin_amdgcn_ds_read_tr16_b64_v4i16((LDS3 s16x4*)(a));
                        const s16x4 hi = __builtin_amdgcn_ds_read_tr16_b64_v4i16((LDS3 s16x4*)(a + 8 * VROW));
                        vf[dt] = __builtin_shufflevector(lo, hi, 0, 1, 2, 3, 4, 5, 6, 7);
                    }
#pragma unroll
                    for (int i = 0; i < 2; ++i)
                        if (use[i]) {
#pragma unroll
                            for (int dt = 0; dt < 2; ++dt) O[i][dt] = MFMA32(vf[dt], pf[i][sub][s], O[i][dt]);
                        }
                }
        }
        }
        if (LAZYLOAD && t + 1 < ntiles) { gload(t + 1); lstore(t + 1); }
        __syncthreads();
    }

    float inv[2];
#pragma unroll
    for (int i = 0; i < 2; ++i) { const float lt = xor32_sum(lrun[i]); inv[i] = 1.0f / lt; }
    bf16_t* ob = p.o + (size_t)b * SEQ * DM;
    if (MODE == MODE_DIFF) {
        const float lam = p.tabs[TAB_LAM + layer];
        const float lambda_init = 0.8f - 0.6f * expf(-0.3f * (float)layer);
        float ss = 0.f;
#pragma unroll
        for (int dt = 0; dt < 2; ++dt)
#pragma unroll
            for (int j = 0; j < 16; ++j) { const float v = O[0][dt][j] * inv[0] - lam * (O[1][dt][j] * inv[1]); O[0][dt][j] = v; ss += v * v; }
        ss = xor32_sum(ss);
        const float rinv = rsqrtf(ss * (1.0f / 64.0f) + 1e-6f) * (1.0f - lambda_init);
        const float* og = p.df_on + layer * 64;
        bf16_t* o = ob + (size_t)qt0 * DM + ocol0 + 4 * h;
#pragma unroll
        for (int dt = 0; dt < 2; ++dt)
#pragma unroll
            for (int g = 0; g < 4; ++g) {
                const float4 gg = *(const float4*)(og + dt * 32 + 8 * g + 4 * h);
                u32x2 pk;
                pk.x = pack2(O[0][dt][4 * g] * rinv * gg.x, O[0][dt][4 * g + 1] * rinv * gg.y);
                pk.y = pack2(O[0][dt][4 * g + 2] * rinv * gg.z, O[0][dt][4 * g + 3] * rinv * gg.w);
                *(u32x2*)(o + dt * 32 + 8 * g) = pk;
            }
    } else {
#pragma unroll
        for (int i = 0; i < 2; ++i) {
            bf16_t* o = ob + (size_t)((i == 0) ? qt0 : qt1) * DM + ((i == 0) ? ocol0 : ocol1) + 4 * h;
#pragma unroll
            for (int dt = 0; dt < 2; ++dt)
#pragma unroll
                for (int g = 0; g < 4; ++g) {
                    u32x2 pk;
                    pk.x = pack2(O[i][dt][4 * g] * inv[i], O[i][dt][4 * g + 1] * inv[i]);
                    pk.y = pack2(O[i][dt][4 * g + 2] * inv[i], O[i][dt][4 * g + 3] * inv[i]);
                    *(u32x2*)(o + dt * 32 + 8 * g) = pk;
                }
        }
    }
}

__device__ void phase_attn(const Params& p, int layer, char* smem, int wv) {
    constexpr int N_DIFF = 512, N_GQA = 256, N_NA = 256, N_DIL = 256;
    const int bid = __builtin_amdgcn_readfirstlane((int)blockIdx.x), G = __builtin_amdgcn_readfirstlane((int)gridDim.x);
    const bool fast_gqa = __builtin_amdgcn_readfirstlane((int)(p.tabs[TAB_BND + 4 * layer] <= 60.0f)) != 0;
    const bool fast_diff = __builtin_amdgcn_readfirstlane((int)(p.tabs[TAB_BND + 4 * layer + 1] <= 60.0f)) != 0;
    const bool fast_dil = __builtin_amdgcn_readfirstlane((int)(p.tabs[TAB_BND + 4 * layer + 3] <= 60.0f)) != 0;
    const bool xmap = (G == 256);
    const int xcd = bid & 7, idx = bid >> 3;
    for (int k = 0; k * G + bid < N_DIFF; ++k) {
        const int it = xmap ? ((2 * xcd + k) * 32 + idx) : (k * G + bid);
        if (fast_diff) attn_item<MODE_DIFF, true>(p, layer, it, smem, wv); else attn_item<MODE_DIFF, false>(p, layer, it, smem, wv);
    }
    for (int k = 0; k * G + bid < N_GQA; ++k) {
        const int it = xmap ? (xcd * 32 + idx) : (k * G + bid);
        if (fast_gqa) attn_item<MODE_GQA, true>(p, layer, it, smem, wv); else attn_item<MODE_GQA, false>(p, layer, it, smem, wv);
    }
    for (int k = 0; k * G + bid < N_NA; ++k) {
        const int it = xmap ? ((2 * xcd + (idx >> 4)) * 16 + (idx & 15)) : (k * G + bid);
        attn_item<MODE_NA, false>(p, layer, it, smem, wv);
    }
    for (int k = 0; k * G + bid < N_DIL; ++k) {
        const int it = xmap ? ((2 * xcd + (idx >> 4)) * 16 + (idx & 15)) : (k * G + bid);
        if (fast_dil) attn_item<MODE_DIL, true>(p, layer, it, smem, wv); else attn_item<MODE_DIL, false>(p, layer, it, smem, wv);
    }
}

#define LAS __attribute__((address_space(3)))
#define XB_TMO      128
#define XB_XCNT(j)  (256  + 64 * (j))
#define XB_XSUB(j)  (1280 + 64 * (j))
#define XB_XGEN(j)  (2304 + 64 * (j))
#define XB_TOP      3328
#define XB_TOPGEN   3392
#define XCD_BAR_WORDS 3456
#define XB_SPIN_CAP (1u << 18)

__device__ __forceinline__ unsigned xb_ld(unsigned* p)              { return __hip_atomic_load(p, __ATOMIC_RELAXED, __HIP_MEMORY_SCOPE_AGENT); }
__device__ __forceinline__ unsigned xb_add(unsigned* p, unsigned v) { return __hip_atomic_fetch_add(p, v, __ATOMIC_RELAXED, __HIP_MEMORY_SCOPE_AGENT); }
__device__ __forceinline__ unsigned xb_xcc_id() { return (unsigned)__builtin_amdgcn_s_getreg((3 << 11) | 20) & 0xFu; }
#define XB_SPIN(cond, bar) do { unsigned _sp = 0; while (cond) { __builtin_amdgcn_s_sleep(1); \
    if ((++_sp & 255u) == 0u) { if (xb_ld(&(bar)[XB_TMO])) break; if (_sp > XB_SPIN_CAP) { atomicAdd(&(bar)[XB_TMO], 1u); break; } } } } while (0)

struct XcdBarrier {
    unsigned* bar; unsigned x; int wv;
    volatile LAS unsigned* st;
};

__device__ __forceinline__ XcdBarrier xcd_barrier_post(unsigned* bar, volatile LAS unsigned* st) {
    XcdBarrier b; b.bar = bar; b.x = xb_xcc_id(); b.st = st; b.wv = __builtin_amdgcn_readfirstlane((int)(threadIdx.x >> 6));
    if (threadIdx.x == 0) (void)xb_add(&bar[XB_XCNT(b.x)], 1u);
    return b;
}
__device__ __forceinline__ void xcd_barrier_complete(unsigned* bar, unsigned x, unsigned& nloc, unsigned& nx) {
    const unsigned G = gridDim.x * gridDim.y * gridDim.z;
    unsigned sum, cnt, mine, sp = 0u;
    for (;;) {
        sum = 0u; cnt = 0u; mine = 0u;
#pragma unroll
        for (unsigned j = 0; j < 16; ++j) { const unsigned c = xb_ld(&bar[XB_XCNT(j)]); sum += c; cnt += (c > 0u) ? 1u : 0u; mine = (j == x) ? c : mine; }
        if (sum == G) break;
        __builtin_amdgcn_s_sleep(1);
        if ((++sp & 255u) == 0u) { if (xb_ld(&bar[XB_TMO])) break; if (sp > XB_SPIN_CAP) { atomicAdd(&bar[XB_TMO], 1u); break; } }
    }
    nloc = mine > 0u ? mine : 1u; nx = cnt > 0u ? cnt : 1u;
}

__device__ __forceinline__ void xcd_barrier(const XcdBarrier& b) {
    asm volatile("s_waitcnt vmcnt(0)" ::: "memory");
    __syncthreads();
    if (b.wv == 0 && lane_id() == 0) {
        unsigned* bar = b.bar;
        __builtin_amdgcn_s_waitcnt(0);
        unsigned nloc = b.st[0], nx = b.st[1];
        if (nloc == 0u) { xcd_barrier_complete(bar, b.x, nloc, nx); b.st[0] = nloc; b.st[1] = nx; }
        const unsigned old = xb_add(&bar[XB_XSUB(b.x)], 1u);
        const unsigned gen = old / nloc;
        if (old + 1u == (gen + 1u) * nloc) {
            __builtin_amdgcn_fence(__ATOMIC_RELEASE, "agent");
            asm volatile("s_waitcnt vmcnt(0)" ::: "memory");
            const unsigned og = xb_add(&bar[XB_TOP], 1u);
            const unsigned tg = og / nx;
            if (og + 1u == (tg + 1u) * nx) xb_add(&bar[XB_TOPGEN], 1u);
            else XB_SPIN(xb_ld(&bar[XB_TOPGEN]) == tg, bar);
            __builtin_amdgcn_fence(__ATOMIC_ACQUIRE, "agent");
            xb_add(&bar[XB_XGEN(b.x)], 1u);
            asm volatile("s_waitcnt vmcnt(0)" ::: "memory");
        } else {
            XB_SPIN(xb_ld(&bar[XB_XGEN(b.x)]) == gen, bar);
            __builtin_amdgcn_fence(__ATOMIC_ACQUIRE, "agent");
            asm volatile("s_waitcnt vmcnt(0)" ::: "memory");
        }
    }
    __syncthreads();
}

constexpr int LDS_BYTES = 131072 + 11 * 256 * 4 + 16;
constexpr int XB_LDS_OFF = 131072 + 11 * 256 * 4;

__global__ void __launch_bounds__(512, 2) fwd_megakernel(Params p) {
    extern __shared__ __attribute__((aligned(16))) unsigned char lds[];
    char* smem = (char*)lds;
    cg::grid_group grid = cg::this_grid();
    if (threadIdx.x < 4) ((volatile LAS unsigned*)(lds + XB_LDS_OFF))[threadIdx.x] = 0u;
    __syncthreads();
    const XcdBarrier xb = xcd_barrier_post(p.bar, (volatile LAS unsigned*)(lds + XB_LDS_OFF));
    const int wv = xb.wv;
    phase_wprep(p, smem, wv);
    phase_init_x(p.x, p.out, p.h, p.ss, wv);
    if (p.bar == nullptr) grid.sync();
    xcd_barrier(xb);
    for (int l = 0; l < NLAYER; ++l) {
        const bf16_t* wl = p.wb + (size_t)l * W_LAYER;
        float* ss0 = p.ss + (size_t)(3 * l) * T_TOK * 16; float* ss1 = ss0 + T_TOK * 16; float* ss2 = ss1 + T_TOK * 16; float* ss3 = ss2 + T_TOK * 16;
        run_gemm(lds, p.h, wl + W_GU1, 2 * DFF, DM, pg8::EpiSwiglu{p.big, DFF, ss0, nullptr}, wv);
        xcd_barrier(xb);
        if (l == 0) run_gemm(lds, p.big, wl + W_D1, DM, DFF, pg8::EpiResid<true, false>{p.x, nullptr, DM, 0.5f, p.h, p.xl, ss1}, wv);
        else        run_gemm(lds, p.big, wl + W_D1, DM, DFF, pg8::EpiResid<false, false>{nullptr, nullptr, DM, 0.5f, p.h, p.xl, ss1}, wv);
        xcd_barrier(xb);
        run_gemm(lds, p.h, wl + W_IN, INW, DM, pg8::EpiQkv{p.big, INW, ss1, nullptr}, wv);
        xcd_barrier(xb);
        phase_prep(p, l, wv);
        xcd_barrier(xb);
        phase_attn(p, l, smem, wv);
        xcd_barrier(xb);
        run_gemm(lds, p.o, wl + W_OUT, DM, DM, pg8::EpiResid<false, false>{nullptr, nullptr, DM, 1.0f, p.h, p.xl, ss2}, wv);
        xcd_barrier(xb);
        run_gemm(lds, p.h, wl + W_GU2, 2 * DFF, DM, pg8::EpiSwiglu{p.big, DFF, ss2, nullptr}, wv);
        xcd_barrier(xb);
        if (l + 1 < NLAYER) run_gemm(lds, p.big, wl + W_D2, DM, DFF, pg8::EpiResid<false, false>{nullptr, nullptr, DM, 0.5f, p.h, p.xl, ss3}, wv);
        else                run_gemm(lds, p.big, wl + W_D2, DM, DFF, pg8::EpiResid<false, true>{nullptr, p.out, DM, 0.5f, p.h, p.xl, ss3}, wv);
        if (l + 1 < NLAYER) xcd_barrier(xb);
    }
}

extern "C" void kernel_launch(void* const* d_in, const int* in_sizes, int n_in, void* d_out, int out_size, void* d_ws, size_t ws_size, hipStream_t stream) {
    static int grid_blocks = 0;
    if (!grid_blocks) {
        int dev = 0, cus = 0, per_cu = 0;
        (void)hipGetDevice(&dev);
        (void)hipDeviceGetAttribute(&cus, hipDeviceAttributeMultiprocessorCount, dev);
        if (hipFuncSetAttribute((const void*)fwd_megakernel, hipFuncAttributeMaxDynamicSharedMemorySize, LDS_BYTES) != hipSuccess) fprintf(stderr, "hipFuncSetAttribute failed\n");
        (void)hipOccupancyMaxActiveBlocksPerMultiprocessor(&per_cu, (const void*)fwd_megakernel, 512, LDS_BYTES);
        if (per_cu < 1) fprintf(stderr, "occupancy query reports %d blocks per CU\n", per_cu);
        (void)hipGetLastError();
        grid_blocks = cus;
    }
    Params p{};
    p.x = (const float*)d_in[0];
    p.ffn1_norm = (const float*)d_in[1]; p.ffn1_wg = (const float*)d_in[2]; p.ffn1_wu = (const float*)d_in[3]; p.ffn1_wd = (const float*)d_in[4];
    p.mix_norm = (const float*)d_in[5]; p.w_in = (const float*)d_in[6]; p.w_out = (const float*)d_in[7];
    p.na_qn = (const float*)d_in[8]; p.na_kn = (const float*)d_in[9]; p.na_bias = (const float*)d_in[10];
    p.df_qn = (const float*)d_in[11]; p.df_kn = (const float*)d_in[12];
    p.lq1 = (const float*)d_in[13]; p.lk1 = (const float*)d_in[14]; p.lq2 = (const float*)d_in[15]; p.lk2 = (const float*)d_in[16];
    p.df_on = (const float*)d_in[17]; p.gq_qn = (const float*)d_in[18]; p.gq_kn = (const float*)d_in[19];
    p.dl_qn = (const float*)d_in[20]; p.dl_kn = (const float*)d_in[21];
    p.ffn2_norm = (const float*)d_in[22]; p.ffn2_wg = (const float*)d_in[23]; p.ffn2_wu = (const float*)d_in[24]; p.ffn2_wd = (const float*)d_in[25];
    p.out = (float*)d_out;
    char* ws = (char*)d_ws;
    size_t off = 0;
    p.wb = (bf16_t*)(ws + off); off += (size_t)W_LAYER * NLAYER * 2;
    p.h = (bf16_t*)(ws + off); off += (size_t)T_TOK * DM * 2;
    p.o = (bf16_t*)d_out;
    p.xl = (unsigned char*)(ws + off); off += (size_t)T_TOK * DM;
    p.ss = (float*)(ws + off); off += (size_t)13 * T_TOK * 16 * 4;
    p.big = (bf16_t*)(ws + off); off += (size_t)T_TOK * INW * 2;
    p.tabs = (float*)(ws + off); off += (size_t)TAB_TOTAL * 4;
    off = (off + 255) & ~(size_t)255;
    p.bar = (unsigned*)(ws + off); off += (size_t)XCD_BAR_WORDS * 4;
    if (off > ws_size) { fprintf(stderr, "workspace too small: need %zu have %zu\n", off, ws_size); return; }
    if (hipMemsetAsync(p.bar, 0, (size_t)XCD_BAR_WORDS * 4, stream) != hipSuccess) { fprintf(stderr, "memset of barrier words failed\n"); return; }
    void* args[] = {&p};
    hipError_t e = hipLaunchCooperativeKernel((void*)fwd_megakernel, dim3(grid_blocks), dim3(512), args, LDS_BYTES, stream);
    if (e != hipSuccess) fprintf(stderr, "cooperative launch failed: %s (grid %d)\n", hipGetErrorString(e), grid_blocks);
}
```

```cpp
#include <hip/hip_runtime.h>
#include <hip/hip_cooperative_groups.h>
#include <cstdio>
#include <cstdint>
namespace cg = cooperative_groups;

typedef unsigned short bf16_t;
typedef short bf16x8 __attribute__((ext_vector_type(8)));
typedef short s16x4 __attribute__((ext_vector_type(4)));
typedef float f32x16 __attribute__((ext_vector_type(16)));
typedef float f32x2 __attribute__((ext_vector_type(2)));
typedef float f32x4 __attribute__((ext_vector_type(4)));
typedef __bf16 bf16v2 __attribute__((ext_vector_type(2)));
typedef unsigned u32x4 __attribute__((ext_vector_type(4)));
typedef unsigned u32x2 __attribute__((ext_vector_type(2)));

#define DI __device__ __forceinline__
#define LDS3 __attribute__((address_space(3)))

constexpr int T_TOK = 32768, SEQ = 8192, DM = 1024, DFF = 2816, INW = 2816, NLAYER = 4;
constexpr float LOG2E = 1.4426950408889634f;
constexpr float NEGF = -1e30f;
constexpr int LDSROW = 72;
constexpr int VROW = 96;
constexpr int KVBUF = 64 * LDSROW + 64 * VROW;

constexpr size_t W_GU1 = 0, W_D1 = 5767168, W_IN = 8650752, W_OUT = 11534336, W_GU2 = 12582912, W_D2 = 18350080, W_LAYER = 21233664;
constexpr int TAB_DIFF = 0, TAB_DIL = 65536, TAB_ROW = 196608, TAB_COL = 200704, TAB_LAM = 202752, TAB_BND = 202756, TAB_TOTAL = 202776;

struct Params {
    const float* x;
    const float *ffn1_norm, *ffn1_wg, *ffn1_wu, *ffn1_wd, *mix_norm, *w_in, *w_out;
    const float *na_qn, *na_kn, *na_bias, *df_qn, *df_kn, *lq1, *lk1, *lq2, *lk2, *df_on, *gq_qn, *gq_kn, *dl_qn, *dl_kn;
    const float *ffn2_norm, *ffn2_wg, *ffn2_wu, *ffn2_wd;
    float* out;
    bf16_t* wb;
    bf16_t* h;
    bf16_t* o;
    unsigned char* xl;
    float* ss;
    bf16_t* big;
    float* tabs;
    unsigned* bar;
};

DI float bf2f(unsigned v) { return __uint_as_float(v << 16); }
DI unsigned pack2(float a, float b) {
    bf16v2 r = __builtin_convertvector((f32x2){a, b}, bf16v2);
    return __builtin_bit_cast(unsigned, r);
}
DI f32x16 zero16() { f32x16 z; for (int i = 0; i < 16; ++i) z[i] = 0.f; return z; }
DI int lane_id() { return (int)__builtin_amdgcn_mbcnt_hi(~0u, __builtin_amdgcn_mbcnt_lo(~0u, 0u)); }
DI int otid(int wv) { int l; asm volatile("v_mbcnt_lo_u32_b32 %0, -1, 0\n\tv_mbcnt_hi_u32_b32 %0, -1, %0" : "=v"(l)); return (wv << 6) | l; }
DI float xor32_max(float x) { const auto r = __builtin_amdgcn_permlane32_swap(__float_as_uint(x), __float_as_uint(x), false, false); return fmaxf(__uint_as_float(r[0]), __uint_as_float(r[1])); }
DI float xor32_sum(float x) { const auto r = __builtin_amdgcn_permlane32_swap(__float_as_uint(x), __float_as_uint(x), false, false); return __uint_as_float(r[0]) + __uint_as_float(r[1]); }
DI float fsub_s(float a, float b) { float r; asm("v_sub_f32_e32 %0, %1, %2" : "=v"(r) : "v"(a), "v"(b)); return r; }
#define MFMA32(a, b, c) __builtin_amdgcn_mfma_f32_32x32x16_bf16((a), (b), (c), 0, 0, 0)

__device__ void wprep_tile(const float* __restrict__ src, int c0, int ldn, bf16_t* __restrict__ dst, int K, int n0, int k0,
                           float* tile, const float* __restrict__ gain, int wv) {
    const int tid = otid(wv);
    f32x4 v[8];
#pragma unroll
    for (int i = 0; i < 8; ++i) {
        const int e = tid + 512 * i, k = e >> 4, c4 = e & 15;
        v[i] = *(const f32x4*)(src + (size_t)(k0 + k) * ldn + c0 + 4 * c4);
    }
    __syncthreads();
#pragma unroll
    for (int i = 0; i < 8; ++i) {
        const int e = tid + 512 * i, k = e >> 4, c4 = e & 15;
        const float g = gain ? gain[k0 + k] : 1.0f;
#pragma unroll
        for (int j = 0; j < 4; ++j) tile[(4 * c4 + j) * 257 + k] = v[i][j] * g;
    }
    __syncthreads();
#pragma unroll
    for (int i = 0; i < 4; ++i) {
        const int e = tid + 512 * i, kc = (e & 3) + 4 * (e >> 8), nn = (e >> 2) & 63;
        const float* t = tile + nn * 257 + 8 * kc;
        u32x4 w; w.x = pack2(t[0], t[1]); w.y = pack2(t[2], t[3]); w.z = pack2(t[4], t[5]); w.w = pack2(t[6], t[7]);
        *(u32x4*)(dst + (size_t)(n0 + nn) * K + k0 + 8 * kc) = w;
    }
}

__device__ void phase_wprep(const Params& p, char* smem, int wv) {
    float* tile = (float*)smem;
    constexpr int PER_LAYER = 352 + 176 + 176 + 64 + 352 + 176;
    for (int id = blockIdx.x; id < PER_LAYER * NLAYER; id += gridDim.x) {
        const int l = id / PER_LAYER; int r = id % PER_LAYER;
        bf16_t* wl = p.wb + (size_t)l * W_LAYER;
        if (r < 352) {
            const int j = r >> 2, kt = r & 3, j2 = j >> 2, q = j & 3;
            const float* s = ((q < 2) ? p.ffn1_wg : p.ffn1_wu) + (size_t)l * DM * DFF;
            wprep_tile(s, 128 * j2 + 64 * (q & 1), DFF, wl + W_GU1, DM, 64 * j, 256 * kt, tile, p.ffn1_norm + l * DM, wv);
            continue;
        }
        r -= 352;
        if (r < 176) {
            const int j = r / 11, kt = r % 11;
            wprep_tile(p.ffn1_wd + (size_t)l * DFF * DM, 64 * j, DM, wl + W_D1, DFF, 64 * j, 256 * kt, tile, nullptr, wv);
            continue;
        }
        r -= 176;
        if (r < 176) {
            const int j = r >> 2, kt = r & 3;
            wprep_tile(p.w_in + (size_t)l * DM * INW, 64 * j, INW, wl + W_IN, DM, 64 * j, 256 * kt, tile, p.mix_norm + l * DM, wv);
            continue;
        }
        r -= 176;
        if (r < 64) {
            const int j = r >> 2, kt = r & 3;
            wprep_tile(p.w_out + (size_t)l * DM * DM, 64 * j, DM, wl + W_OUT, DM, 64 * j, 256 * kt, tile, nullptr, wv);
            continue;
        }
        r -= 64;
        if (r < 352) {
            const int j = r >> 2, kt = r & 3, j2 = j >> 2, q = j & 3;
            const float* s = ((q < 2) ? p.ffn2_wg : p.ffn2_wu) + (size_t)l * DM * DFF;
            wprep_tile(s, 128 * j2 + 64 * (q & 1), DFF, wl + W_GU2, DM, 64 * j, 256 * kt, tile, p.ffn2_norm + l * DM, wv);
            continue;
        }
        r -= 352;
        {
            const int j = r / 11, kt = r % 11;
            wprep_tile(p.ffn2_wd + (size_t)l * DFF * DM, 64 * j, DM, wl + W_D2, DFF, 64 * j, 256 * kt, tile, nullptr, wv);
        }
    }
    const int gtid = blockIdx.x * 512 + otid(wv), gstride = gridDim.x * 512;
    float2* tabs2 = (float2*)p.tabs;
    for (int e = gtid; e < 8192 * 4; e += gstride) {
        const int pos = e >> 2, i = e & 3;
        const float inv = 1.0f / powf(500000.0f, (float)(2 * i) / 8.0f);
        const float ang = (float)pos * inv;
        tabs2[TAB_DIFF / 2 + e] = make_float2(cosf(ang), sinf(ang));
    }
    for (int e = gtid; e < 8192 * 8; e += gstride) {
        const int pos = e >> 3, i = e & 7;
        const float inv = 1.0f / powf(500000.0f, (float)(2 * i) / 16.0f);
        const float ang = (float)pos * inv;
        tabs2[TAB_DIL / 2 + e] = make_float2(cosf(ang), sinf(ang));
    }
    for (int e = gtid; e < 128 * 16; e += gstride) {
        const int pos = e >> 4, i = e & 15;
        const float inv = 1.0f / powf(10000.0f, (float)(2 * i) / 32.0f);
        const float ang = (float)pos * inv;
        tabs2[TAB_ROW / 2 + e] = make_float2(cosf(ang), sinf(ang));
    }
    for (int e = gtid; e < 64 * 16; e += gstride) {
        const int pos = e >> 4, i = e & 15;
        const float inv = 1.0f / powf(10000.0f, (float)(2 * i) / 32.0f);
        const float ang = (float)pos * inv;
        tabs2[TAB_COL / 2 + e] = make_float2(cosf(ang), sinf(ang));
    }
    if (gtid < NLAYER) {
        const int l = gtid; float s1 = 0.f, s2 = 0.f;
        for (int i = 0; i < 32; ++i) { s1 += p.lq1[l * 32 + i] * p.lk1[l * 32 + i]; s2 += p.lq2[l * 32 + i] * p.lk2[l * 32 + i]; }
        const float lambda_init = 0.8f - 0.6f * expf(-0.3f * (float)l);
        p.tabs[TAB_LAM + l] = expf(s1) - expf(s2) + lambda_init;
        float gq = 0.f, gk = 0.f, dq = 0.f, dk = 0.f;
        for (int i = 0; i < 64; ++i) { gq = fmaxf(gq, fabsf(p.gq_qn[l * 64 + i])); gk = fmaxf(gk, fabsf(p.gq_kn[l * 64 + i])); }
        for (int i = 0; i < 32; ++i) { dq = fmaxf(dq, fabsf(p.df_qn[l * 32 + i])); dk = fmaxf(dk, fabsf(p.df_kn[l * 32 + i])); }
        float lq = 0.f, lk = 0.f;
        for (int i = 0; i < 64; ++i) { lq = fmaxf(lq, fabsf(p.dl_qn[l * 64 + i])); lk = fmaxf(lk, fabsf(p.dl_kn[l * 64 + i])); }
        p.tabs[TAB_BND + 4 * l] = 8.0f * gq * gk * LOG2E * 1.02f;
        p.tabs[TAB_BND + 4 * l + 1] = 5.656854249f * dq * dk * LOG2E * 1.02f;
        p.tabs[TAB_BND + 4 * l + 3] = 8.0f * lq * lk * LOG2E * 1.02f;
    }
}

__device__ void phase_init_x(const float* __restrict__ src, float* __restrict__ copy_dst, bf16_t* __restrict__ h, float* __restrict__ ss, int wv) {
    const int tid0 = otid(wv); const int lane = tid0 & 63, w = tid0 >> 6;
    for (int row = blockIdx.x * 8 + w; row < T_TOK; row += gridDim.x * 8) {
        float4 v[4]; float acc = 0.f;
#pragma unroll
        for (int i = 0; i < 4; ++i) {
            v[i] = *(const float4*)(src + (size_t)row * DM + (i * 64 + lane) * 4);
            u32x2 pk; pk.x = pack2(v[i].x, v[i].y); pk.y = pack2(v[i].z, v[i].w);
            acc += v[i].x * v[i].x + v[i].y * v[i].y + v[i].z * v[i].z + v[i].w * v[i].w;
            *(u32x2*)(h + (size_t)row * DM + (i * 64 + lane) * 4) = pk;
        }
#pragma unroll
        for (int o = 32; o >= 1; o >>= 1) acc += __shfl_xor(acc, o);
        if (lane < 16) ss[(size_t)row * 16 + lane] = (lane == 0) ? acc : 0.f;
    }
}

namespace pg8 {
#define PG8_LAS __attribute__((address_space(3)))
constexpr int BM = 256, BK = 64, HALF = 128, HTB = HALF * BK * 2  , STAGE_BYTES = 8 * HTB, NXCD = 8, WGM = 8;

__host__ __device__ __forceinline__ int lds_byte(int r, int c) { const int st = (r >> 4) * 2 + (c >> 5), rr = r & 15, cc = c & 31, ob = rr * 64 + cc * 2; return st * 1024 + (ob ^ (((ob >> 9) & 1) << 5)); }
__host__ __device__ __forceinline__ void stage_rc(int b, int& R, int& C) { const int st = b / 1024, sb = b % 1024, swz = sb ^ (((sb >> 9) & 1) << 5); R = (st >> 1) * 16 + swz / 64; C = (st & 1) * 32 + (swz % 64) / 2; }
__host__ __device__ __forceinline__ int perm32(int rho) { const int n = rho >> 4, i = rho & 15; return 8 * (i >> 2) + 4 * n + (i & 3); }

struct Unit { int pm, pn; };
struct Gemm { const bf16_t* A; const bf16_t* Bt; int M, N, K; };

struct StaticOrder {
    int nM, nN, nwg, G, c;
    __host__ __device__ void init(int M, int N, int G_, int c_) { nM = M / BM; nN = N / BM; nwg = nM * nN; G = G_; c = c_; }
    __host__ __device__ bool next(int i, Unit& u) const {
        const int L = i * G + c; if (L >= nwg) return false;
        int wgid = (int)L; { const int q = nwg / NXCD, r = nwg % NXCD, xcd = wgid % NXCD, off = wgid / NXCD; wgid = (xcd < r ? xcd * (q + 1) : r * (q + 1) + (xcd - r) * q) + off; }
        const int nig = WGM * nN, gid = wgid / nig, fm = gid * WGM, gsz = (nM - fm) < WGM ? (nM - fm) : WGM;
        u.pm = fm + ((wgid % nig) % gsz); u.pn = (wgid % nig) / gsz; return true;
    }
    __device__ __forceinline__ void a_ready(const Unit&) const {}
    __device__ __forceinline__ void done(const Unit&) const {}
};

__device__ __forceinline__ float row_rinv(const float* sp) {
    const f32x4 a = *(const f32x4*)sp, b = *(const f32x4*)(sp + 4), c = *(const f32x4*)(sp + 8), d = *(const f32x4*)(sp + 12);
    const float t = (((a[0] + a[1]) + (a[2] + a[3])) + ((b[0] + b[1]) + (b[2] + b[3]))) + (((c[0] + c[1]) + (c[2] + c[3])) + ((d[0] + d[1]) + (d[2] + d[3])));
    return rsqrtf(t * (1.0f / DM) + 1e-6f);
}
struct EpiQkv {
    static constexpr bool PERM = true, AFTER_DRAIN = false;
    static constexpr bool NEEDS_RINV = true;
    bf16_t* O; int ldc; const float* ss; const PG8_LAS float* rinvT;
    __device__ __forceinline__ void operator()(const f32x4 (&acc)[2][2][4][2], const Unit& u, int ui, int wr, int wc, int fr, int fq) const {
        const int row0 = u.pm * BM + wr * 64 + fr, col0 = u.pn * BM + wc * 32 + 8 * fq;
#pragma unroll
        for (int ai = 0; ai < 2; ++ai)
#pragma unroll
            for (int m = 0; m < 4; ++m) { bf16_t* rowp = O + (size_t)(row0 + ai * HALF + m * 16) * ldc + col0;
                const float rinv = rinvT[ui * 256 + wr * 64 + ai * HALF + m * 16 + fr];
#pragma unroll
                for (int bj = 0; bj < 2; ++bj) { const f32x4 v0 = acc[ai][bj][m][0] * rinv, v1 = acc[ai][bj][m][1] * rinv;
                    u32x4 w; w.x = pack2(v0[0], v0[1]); w.y = pack2(v0[2], v0[3]); w.z = pack2(v1[0], v1[1]); w.w = pack2(v1[2], v1[3]);
                    *(u32x4*)(rowp + bj * HALF) = w; } }
    }
};
struct EpiSwiglu {
    static constexpr bool PERM = true, AFTER_DRAIN = false;
    static constexpr bool NEEDS_RINV = true;
    bf16_t* O; int ldc; const float* ss; const PG8_LAS float* rinvT;
    __device__ __forceinline__ void operator()(const f32x4 (&acc)[2][2][4][2], const Unit& u, int ui, int wr, int wc, int fr, int fq) const {
        const int row0 = u.pm * BM + wr * 64 + fr, col0 = u.pn * HALF + wc * 32 + 8 * fq;
#pragma unroll
        for (int ai = 0; ai < 2; ++ai)
#pragma unroll
            for (int m = 0; m < 4; ++m) {
                const float rinv = rinvT[ui * 256 + wr * 64 + ai * HALF + m * 16 + fr];
                const float c1 = rinv * -LOG2E, r2 = rinv * rinv;
                float r[8];
#pragma unroll
                for (int n = 0; n < 2; ++n)
#pragma unroll
                    for (int e = 0; e < 4; ++e) { const float ga = acc[ai][0][m][n][e], ua = acc[ai][1][m][n][e];
                        r[4 * n + e] = (ga * ua) * (r2 * __builtin_amdgcn_rcpf(1.0f + __builtin_amdgcn_exp2f(ga * c1))); }
                u32x4 w; w.x = pack2(r[0], r[1]); w.y = pack2(r[2], r[3]); w.z = pack2(r[4], r[5]); w.w = pack2(r[6], r[7]);
                *(u32x4*)(O + (size_t)(row0 + ai * HALF + m * 16) * ldc + col0) = w; }
    }
};
template <bool IN32, bool OUT32>
struct EpiResid {
    static constexpr bool PERM = true, AFTER_DRAIN = false;
    static constexpr bool NEEDS_RINV = false;
    const float* Xin32; float* Xout32; int ldc; float alpha; bf16_t* H; unsigned char* L; float* ss;
    __device__ __forceinline__ void operator()(const f32x4 (&acc)[2][2][4][2], const Unit& u, int ui, int wr, int wc, int fr, int fq) const {
        const int row0 = u.pm * BM + wr * 64 + fr, col0 = u.pn * BM + wc * 32 + 8 * fq;
#pragma unroll
        for (int ai = 0; ai < 2; ++ai) {
            u32x4 raw[4][2][2];
#pragma unroll
            for (int m = 0; m < 4; ++m) { const size_t off = (size_t)(row0 + ai * HALF + m * 16) * ldc + col0;
#pragma unroll
                for (int bj = 0; bj < 2; ++bj) {
                    if constexpr (IN32) { raw[m][bj][0] = *(const u32x4*)(Xin32 + off + bj * HALF); raw[m][bj][1] = *(const u32x4*)(Xin32 + off + bj * HALF + 4); }
                    else { raw[m][bj][0] = *(const u32x4*)(H + off + bj * HALF); const u32x2 l2 = *(const u32x2*)(L + off + bj * HALF); raw[m][bj][1] = (u32x4){l2.x, l2.y, 0u, 0u}; } } }
#pragma unroll
            for (int m = 0; m < 4; ++m) { const int row = row0 + ai * HALF + m * 16; const size_t off = (size_t)row * ldc + col0;
                float sq = 0.f;
#pragma unroll
                for (int bj = 0; bj < 2; ++bj) {
                    float x[8];
                    if constexpr (IN32) {
#pragma unroll
                        for (int c = 0; c < 4; ++c) { x[c] = __uint_as_float(raw[m][bj][0][c]); x[4 + c] = __uint_as_float(raw[m][bj][1][c]); }
                    } else {
#pragma unroll
                        for (int c2 = 0; c2 < 2; ++c2) {
                            const int lw = (int)raw[m][bj][1][c2];
                            const f32x2 l01 = __builtin_amdgcn_cvt_pk_f32_fp8(lw, false), l23 = __builtin_amdgcn_cvt_pk_f32_fp8(lw, true);
                            const unsigned h0 = raw[m][bj][0][2 * c2], h1 = raw[m][bj][0][2 * c2 + 1];
                            x[4 * c2 + 0] = __uint_as_float(h0 << 16) + l01.x * (1.0f / 256.0f); x[4 * c2 + 1] = __uint_as_float(h0 & 0xffff0000u) + l01.y * (1.0f / 256.0f);
                            x[4 * c2 + 2] = __uint_as_float(h1 << 16) + l23.x * (1.0f / 256.0f); x[4 * c2 + 3] = __uint_as_float(h1 & 0xffff0000u) + l23.y * (1.0f / 256.0f);
                        }
                    }
#pragma unroll
                    for (int c = 0; c < 4; ++c) { x[c] += alpha * acc[ai][bj][m][0][c]; x[4 + c] += alpha * acc[ai][bj][m][1][c]; }
                    if constexpr (OUT32) {
                        *(f32x4*)(Xout32 + off + bj * HALF) = (f32x4){x[0], x[1], x[2], x[3]}; *(f32x4*)(Xout32 + off + bj * HALF + 4) = (f32x4){x[4], x[5], x[6], x[7]};
                    } else {
#pragma unroll
                        for (int c = 0; c < 8; ++c) sq += x[c] * x[c];
                        u32x4 hw4; float r[8];
#pragma unroll
                        for (int c = 0; c < 4; ++c) {
                            const unsigned hw = pack2(x[2 * c], x[2 * c + 1]);
                            hw4[c] = hw; r[2 * c] = __builtin_amdgcn_fmed3f((x[2 * c] - __uint_as_float(hw << 16)) * 256.0f, -440.0f, 440.0f); r[2 * c + 1] = __builtin_amdgcn_fmed3f((x[2 * c + 1] - __uint_as_float(hw & 0xffff0000u)) * 256.0f, -440.0f, 440.0f);
                        }
                        u32x2 lw2;
#pragma unroll
                        for (int c2 = 0; c2 < 2; ++c2) {
                            int w = __builtin_amdgcn_cvt_pk_fp8_f32(r[4 * c2], r[4 * c2 + 1], 0, false);
                            w = __builtin_amdgcn_cvt_pk_fp8_f32(r[4 * c2 + 2], r[4 * c2 + 3], w, true);
                            lw2[c2] = (unsigned)w;
                        }
                        *(u32x4*)(H + off + bj * HALF) = hw4; *(u32x2*)(L + off + bj * HALF) = lw2;
                    }
                }
                if constexpr (!OUT32) { sq += __shfl_xor(sq, 16); sq += __shfl_xor(sq, 32);
                    if (fq == 0) ss[(size_t)row * 16 + u.pn * 4 + wc] = sq; }
            }
        }
    }
};


template <class Epi, class Sched, bool ALIGN_EPI = false, bool SP2 = false>
__device__ __forceinline__ void gemm_phase(PG8_LAS unsigned char* lds, const Gemm g, const Sched& S, const Epi& E, int wv) {
    const int tid = otid(wv), wid = __builtin_amdgcn_readfirstlane(tid >> 6), lane = tid & 63, wr = wid >> 2, wc = wid & 3, fr = lane & 15, fq = lane >> 4;
    const int K = g.K, nt = K / BK;
    unsigned voffA[2], voffB[2];
#pragma unroll
    for (int i = 0; i < 2; ++i) { int R, C; stage_rc(tid * 16 + i * 8192, R, C); const int Rb = Epi::PERM ? ((R & ~31) + perm32(R & 31)) : R;
        voffA[i] = (unsigned)(R * K + C) * 2u; voffB[i] = (unsigned)(Rb * K + C) * 2u; }
    const size_t kstep = (size_t)(BK * 2);
    const size_t hstep = (size_t)HALF * K * 2;
    const size_t tstep = 2 * hstep;
    const unsigned ldsw = (unsigned)wid * 1024u;
    const int aoff = lds_byte(wr * 64 + fr, fq * 8), boff = lds_byte(wc * 32 + fr, fq * 8);
#define PG8_SA(b, h) (((b) * 2 + (h)) * HTB)
#define PG8_SB(b, h) ((4 + (b) * 2 + (h)) * HTB)
#define PG8_STAGE(bufoff, gbase, voff) do { _Pragma("unroll") for (int _i = 0; _i < 2; ++_i) \
        __builtin_amdgcn_global_load_lds((const unsigned*)((const char*)(gbase) + (voff)[_i]), (PG8_LAS unsigned*)(lds + (bufoff) + ldsw + _i * 8192), 16, 0, 0); } while (0)
#define PG8_LDA(dst, b, h) do { _Pragma("unroll") for (int m = 0; m < 4; ++m) _Pragma("unroll") for (int k = 0; k < 2; ++k) dst[m][k] = *(const PG8_LAS bf16x8*)(lds + PG8_SA(b, h) + aoff + m * 2048 + k * 1024); } while (0)
#define PG8_LDB(dst, b, h) do { _Pragma("unroll") for (int n = 0; n < 2; ++n) _Pragma("unroll") for (int k = 0; k < 2; ++k) dst[n][k] = *(const PG8_LAS bf16x8*)(lds + PG8_SB(b, h) + boff + n * 2048 + k * 1024); } while (0)
#define PG8_MMA(ai, bj, At, Bt) do { __builtin_amdgcn_s_setprio(1); _Pragma("unroll") for (int m = 0; m < 4; ++m) _Pragma("unroll") for (int n = 0; n < 2; ++n) _Pragma("unroll") for (int k = 0; k < 2; ++k) \
        acc[ai][bj][m][n] = __builtin_amdgcn_mfma_f32_16x16x32_bf16(Bt[n][k], At[m][k], acc[ai][bj][m][n], 0, 0, 0); __builtin_amdgcn_s_setprio(0); } while (0)
#define PG8_WAIT_V(n) asm volatile("s_waitcnt vmcnt(" #n ")" ::: "memory")
#define PG8_WAIT_L(n) asm volatile("s_waitcnt lgkmcnt(" #n ")" ::: "memory")
#define PG8_BAR __builtin_amdgcn_s_barrier()
#define PG8_SCHED __builtin_amdgcn_sched_barrier(0)
    Unit cur, nxt; int ui = 0;
    if (!S.next(0, cur)) return;
    f32x4 acc[2][2][4][2];
#pragma unroll
    for (int a = 0; a < 2; ++a)
#pragma unroll
        for (int b = 0; b < 2; ++b)
#pragma unroll
            for (int m = 0; m < 4; ++m)
#pragma unroll
                for (int n = 0; n < 2; ++n) acc[a][b][m][n] = (f32x4){0.f, 0.f, 0.f, 0.f};
    bf16x8 At[4][2], B0[2][2], B1[2][2];
    const char* cA = (const char*)g.A + (size_t)cur.pm * tstep; const char* cB = (const char*)g.Bt + (size_t)cur.pn * tstep;
    S.a_ready(cur);
    if constexpr (SP2) {
        PG8_STAGE(PG8_SB(0, 0), cB, voffB); PG8_STAGE(PG8_SB(0, 1), cB + hstep, voffB); PG8_STAGE(PG8_SA(0, 0), cA, voffA); PG8_STAGE(PG8_SA(0, 1), cA + hstep, voffA);
        if (wr == 1) PG8_BAR;
        PG8_WAIT_V(2); PG8_BAR;
        PG8_STAGE(PG8_SB(1, 0), cB + kstep, voffB); PG8_STAGE(PG8_SA(1, 0), cA + kstep, voffA); PG8_STAGE(PG8_SB(1, 1), cB + hstep + kstep, voffB);
        PG8_WAIT_V(6); PG8_BAR;
    } else {
        PG8_STAGE(PG8_SB(0, 0), cB, voffB); PG8_STAGE(PG8_SA(0, 0), cA, voffA); PG8_STAGE(PG8_SB(0, 1), cB + hstep, voffB); PG8_STAGE(PG8_SA(0, 1), cA + hstep, voffA);
        if (wr == 1) PG8_BAR;
        PG8_WAIT_V(4); PG8_BAR;
        PG8_STAGE(PG8_SB(1, 0), cB + kstep, voffB); PG8_STAGE(PG8_SA(1, 0), cA + kstep, voffA); PG8_STAGE(PG8_SB(1, 1), cB + hstep + kstep, voffB);
        PG8_WAIT_V(6); PG8_BAR;
    }
    for (;;) {
        const bool has_next = S.next(ui + 1, nxt);
        const char* nA = has_next ? (const char*)g.A + (size_t)nxt.pm * tstep : cA; const char* nB = has_next ? (const char*)g.Bt + (size_t)nxt.pn * tstep : cB;
        for (int t = 0; t < nt; t += 2) {
            const bool last = (t == nt - 2);
            const char* a1 = cA + (size_t)(t + 1) * kstep;
            const char* a2 = last ? nA : cA + (size_t)(t + 2) * kstep; const char* b2 = last ? nB : cB + (size_t)(t + 2) * kstep;
            const char* a3 = a2 + kstep; const char* b3 = b2 + kstep;
            if (last && has_next) S.a_ready(nxt);
            if constexpr (SP2) {
            PG8_LDB(B0, 0, 0); PG8_LDB(B1, 0, 1); PG8_SCHED; PG8_LDA(At, 0, 0); PG8_STAGE(PG8_SA(1, 1), a1 + hstep, voffA);
            PG8_WAIT_V(8); PG8_WAIT_L(0); PG8_BAR; PG8_MMA(0, 0, At, B0); PG8_MMA(0, 1, At, B1); PG8_BAR; PG8_SCHED;
            PG8_LDA(At, 0, 1); PG8_STAGE(PG8_SB(0, 0), b2, voffB); PG8_STAGE(PG8_SB(0, 1), b2 + hstep, voffB); PG8_STAGE(PG8_SA(0, 0), a2, voffA);
            PG8_WAIT_V(8); PG8_WAIT_L(0); PG8_BAR; PG8_MMA(1, 0, At, B0); PG8_MMA(1, 1, At, B1); PG8_BAR; PG8_SCHED;
            PG8_LDB(B0, 1, 0); PG8_LDB(B1, 1, 1); PG8_SCHED; PG8_LDA(At, 1, 0); PG8_STAGE(PG8_SA(0, 1), a2 + hstep, voffA);
            PG8_WAIT_V(8); PG8_WAIT_L(0); PG8_BAR; PG8_MMA(0, 0, At, B0); PG8_MMA(0, 1, At, B1); PG8_BAR; PG8_SCHED;
            PG8_LDA(At, 1, 1); PG8_STAGE(PG8_SB(1, 0), b3, voffB); PG8_STAGE(PG8_SB(1, 1), b3 + hstep, voffB); PG8_STAGE(PG8_SA(1, 0), a3, voffA);
            PG8_WAIT_V(8); PG8_WAIT_L(0); PG8_BAR; PG8_MMA(1, 0, At, B0); PG8_MMA(1, 1, At, B1); PG8_BAR; PG8_SCHED;
            } else {
            PG8_LDB(B0, 0, 0); PG8_SCHED; PG8_LDA(At, 0, 0); PG8_STAGE(PG8_SA(1, 1), a1 + hstep, voffA);
            PG8_WAIT_L(8); PG8_BAR; PG8_WAIT_L(0); PG8_MMA(0, 0, At, B0); PG8_BAR; PG8_SCHED;
            PG8_LDB(B1, 0, 1); PG8_STAGE(PG8_SB(0, 0), b2, voffB);
            PG8_BAR; PG8_WAIT_L(0); PG8_MMA(0, 1, At, B1); PG8_BAR;
            PG8_LDA(At, 0, 1); PG8_STAGE(PG8_SA(0, 0), a2, voffA);
            PG8_BAR; PG8_WAIT_L(0); PG8_MMA(1, 0, At, B0); PG8_BAR; PG8_SCHED;
            PG8_STAGE(PG8_SB(0, 1), b2 + hstep, voffB);
            PG8_WAIT_V(6); PG8_BAR; PG8_MMA(1, 1, At, B1); PG8_BAR;
            PG8_LDB(B0, 1, 0); PG8_SCHED; PG8_LDA(At, 1, 0); PG8_STAGE(PG8_SA(0, 1), a2 + hstep, voffA);
            PG8_WAIT_L(8); PG8_BAR; PG8_WAIT_L(0); PG8_MMA(0, 0, At, B0); PG8_BAR; PG8_SCHED;
            PG8_LDB(B1, 1, 1); PG8_STAGE(PG8_SB(1, 0), b3, voffB);
            PG8_BAR; PG8_WAIT_L(0); PG8_MMA(0, 1, At, B1); PG8_BAR;
            PG8_LDA(At, 1, 1); PG8_STAGE(PG8_SA(1, 0), a3, voffA);
            PG8_BAR; PG8_WAIT_L(0); PG8_MMA(1, 0, At, B0); PG8_BAR; PG8_SCHED;
            PG8_STAGE(PG8_SB(1, 1), b3 + hstep, voffB);
            PG8_WAIT_V(6); PG8_BAR; PG8_MMA(1, 1, At, B1); PG8_BAR;
            }
        }
        if constexpr (ALIGN_EPI) { if (wr == 0) PG8_BAR; }
        if constexpr (!Epi::AFTER_DRAIN) { E(acc, cur, ui, wr, wc, fr, fq); S.done(cur); }
        if (!has_next) break;
#pragma unroll
        for (int a = 0; a < 2; ++a)
#pragma unroll
            for (int b = 0; b < 2; ++b)
#pragma unroll
                for (int m = 0; m < 4; ++m)
#pragma unroll
                    for (int n = 0; n < 2; ++n) acc[a][b][m][n] = (f32x4){0.f, 0.f, 0.f, 0.f};
        cur = nxt; cA = nA; cB = nB; ++ui;
        if constexpr (ALIGN_EPI) { if (wr == 1) PG8_BAR; }
    }
    PG8_WAIT_V(0);
    if constexpr (!ALIGN_EPI) { if (wr == 0) PG8_BAR; }
    PG8_BAR;
    if constexpr (Epi::AFTER_DRAIN) { E.fused(acc, cur, wr, wc, fr, fq, lds, wid, lane); S.done(cur); }
#undef PG8_SA
#undef PG8_SB
#undef PG8_STAGE
#undef PG8_LDA
#undef PG8_LDB
#undef PG8_MMA
#undef PG8_WAIT_V
#undef PG8_WAIT_L
#undef PG8_BAR
#undef PG8_SCHED
}
}

constexpr int RINV_OFF = 131072, RINV_MAX_UNITS = 11;
template <class Epi>
__device__ __forceinline__ void run_gemm(unsigned char* lds, const bf16_t* A, const bf16_t* Bt, int N, int K, Epi E, int wv) {
    pg8::Gemm g{A, Bt, T_TOK, N, K}; pg8::StaticOrder S; S.init(T_TOK, N, __builtin_amdgcn_readfirstlane((int)gridDim.x), __builtin_amdgcn_readfirstlane((int)blockIdx.x));
    if constexpr (Epi::NEEDS_RINV) {
        float* tab = (float*)(lds + RINV_OFF);
        const int tid = otid(wv);
        pg8::Unit u;
        for (int i = 0; i < RINV_MAX_UNITS && S.next(i, u); ++i)
            if (tid < 256) tab[i * 256 + tid] = pg8::row_rinv(E.ss + (size_t)(u.pm * 256 + tid) * 16);
        __syncthreads();
        E.rinvT = (const PG8_LAS float*)tab;
    }
    pg8::gemm_phase<Epi, pg8::StaticOrder, true, true>((PG8_LAS unsigned char*)lds, g, S, E, wv);
}

template <int W, int ROPE>
DI void prep_unit(bf16_t* ptr, const float* __restrict__ gain, float scale, const float2* __restrict__ t1, const float2* __restrict__ t2) {
    float v[W];
#pragma unroll
    for (int c = 0; c < W / 8; ++c) {
        const u32x4 u = ((const u32x4*)ptr)[c];
        v[8 * c + 0] = bf2f(u.x & 0xffffu); v[8 * c + 1] = bf2f(u.x >> 16);
        v[8 * c + 2] = bf2f(u.y & 0xffffu); v[8 * c + 3] = bf2f(u.y >> 16);
        v[8 * c + 4] = bf2f(u.z & 0xffffu); v[8 * c + 5] = bf2f(u.z >> 16);
        v[8 * c + 6] = bf2f(u.w & 0xffffu); v[8 * c + 7] = bf2f(u.w >> 16);
    }
    float ss = 0.f;
#pragma unroll
    for (int j = 0; j < W; ++j) ss += v[j] * v[j];
    const float rinv = rsqrtf(ss * (1.0f / W) + 1e-6f);
#pragma unroll
    for (int j = 0; j < W; ++j) v[j] = v[j] * rinv * gain[j];
    if (ROPE == 1) {
        constexpr int HF = W / 8;
#pragma unroll
        for (int i = 0; i < HF; ++i) {
            const float2 cs = t1[i]; const float a = v[i], b = v[i + HF];
            v[i] = a * cs.x - b * cs.y; v[i + HF] = a * cs.y + b * cs.x;
        }
    }
    if (ROPE == 2) {
#pragma unroll
        for (int i = 0; i < 16; ++i) {
            float2 cs = t1[i]; float a = v[i], b = v[i + 16];
            v[i] = a * cs.x - b * cs.y; v[i + 16] = a * cs.y + b * cs.x;
            cs = t2[i]; a = v[32 + i]; b = v[48 + i];
            v[32 + i] = a * cs.x - b * cs.y; v[48 + i] = a * cs.y + b * cs.x;
        }
    }
#pragma unroll
    for (int c = 0; c < W / 8; ++c) {
        u32x4 u;
        u.x = pack2(v[8 * c + 0] * scale, v[8 * c + 1] * scale); u.y = pack2(v[8 * c + 2] * scale, v[8 * c + 3] * scale);
        u.z = pack2(v[8 * c + 4] * scale, v[8 * c + 5] * scale); u.w = pack2(v[8 * c + 6] * scale, v[8 * c + 7] * scale);
        ((u32x4*)ptr)[c] = u;
    }
}

__device__ void phase_prep(const Params& p, int l, int wv) {
    const float SC64 = 0.125f * LOG2E, SC32 = 0.17677669529663687f * LOG2E;
    const float2* tabs2 = (const float2*)p.tabs;
    const int tid0 = otid(wv); const int lane = tid0 & 63;
    const int w = wv;
    const int ntask = (T_TOK / 64) * 18;
    for (int task = blockIdx.x * 8 + w; task < ntask; task += gridDim.x * 8) {
        const int tg = task / 18, u = task - tg * 18;
        const int tok = tg * 64 + lane, pos = tok & (SEQ - 1);
        bf16_t* row = p.big + (size_t)tok * INW;
        if (u < 4) prep_unit<64, 0>(row + 256 + u * 64, p.na_kn + l * 64, 1.0f, nullptr, nullptr);
        else if (u < 12) prep_unit<32, 1>(row + 1024 + (u - 4) * 32, p.df_kn + l * 32, 1.0f, tabs2 + TAB_DIFF / 2 + pos * 4, nullptr);
        else if (u < 14) prep_unit<64, 2>(row + 1792 + (u - 12) * 64, p.gq_kn + l * 64, 1.0f, tabs2 + TAB_ROW / 2 + (pos >> 6) * 16, tabs2 + TAB_COL / 2 + (pos & 63) * 16);
        else prep_unit<64, 1>(row + 2304 + (u - 14) * 64, p.dl_kn + l * 64, 1.0f, tabs2 + TAB_DIL / 2 + pos * 8, nullptr);
    }
}

enum { MODE_GQA = 0, MODE_DIFF = 1, MODE_NA = 2, MODE_DIL = 3 };

DI int clampi(int v, int lo, int hi) { return v < lo ? lo : (v > hi ? hi : v); }

template <int MODE, bool FAST>
__device__ void attn_item(const Params& p, int layer, int item, char* smem, int wv) {
    constexpr int NKS = (MODE == MODE_DIFF) ? 2 : 4;
    const int tid = otid(wv), lane = tid & 63, w = tid >> 6, n = lane & 31, h = lane >> 5;
    bf16_t* KV0 = (bf16_t*)smem;
    float* biasS = (float*)(KV0 + 4 * KVBUF);
    int b, qcol0, qcol1, kcol, vcol, ocol0, ocol1, qt0, qt1, ntiles;
    int na_r = 0, na_rsmin = 0, na_rs = 0, na_nrows = 0, dl_c = 0, dl_g = 0;
    if (MODE == MODE_GQA) {
        b = item >> 6; const int kvh = (item >> 5) & 1, qb = item & 31;
        qt0 = qt1 = 256 * qb + 32 * w + n;
        qcol0 = 1536 + (2 * kvh) * 64; qcol1 = qcol0 + 64; kcol = 1792 + kvh * 64; vcol = 1920 + kvh * 64;
        ocol0 = 512 + (2 * kvh) * 64; ocol1 = ocol0 + 64; ntiles = 128;
    } else if (MODE == MODE_DIFF) {
        b = item >> 7; const int hd = (item >> 5) & 3, qb = item & 31;
        qt0 = qt1 = 256 * qb + 32 * w + n;
        qcol0 = qcol1 = 768 + hd * 64; kcol = 1024 + hd * 64; vcol = 1280 + hd * 64; ocol0 = ocol1 = 256 + hd * 64; ntiles = 128;
    } else if (MODE == MODE_NA) {
        b = item >> 6; const int hd = (item >> 4) & 3, rg = item & 15;
        na_r = 8 * rg + w; na_rs = clampi(na_r - 4, 0, 120);
        na_rsmin = clampi(8 * rg - 4, 0, 120);
        const int rsmax = clampi(8 * rg + 7 - 4, 0, 120) + 7;
        na_nrows = rsmax - na_rsmin + 1; ntiles = 8;
        qt0 = 64 * na_r + n; qt1 = qt0 + 32;
        qcol0 = qcol1 = hd * 64; kcol = 256 + hd * 64; vcol = 512 + hd * 64; ocol0 = ocol1 = hd * 64;
        __syncthreads();
        for (int e = tid; e < 15 * 31; e += 512) biasS[e] = p.na_bias[(size_t)(layer * 4 + hd) * 465 + e] * LOG2E;
    } else {
        b = item >> 6; const int hd = (item >> 4) & 3; dl_c = item & 15; dl_g = 0;
        const int rc4 = (w >> 1);
        qt0 = 512 * dl_c + rc4 + 4 * (2 * (w & 1)) + 16 * n; qt1 = qt0 + 4;
        qcol0 = qcol1 = 2048 + hd * 64; kcol = 2304 + hd * 64; vcol = 2560 + hd * 64; ocol0 = ocol1 = 768 + hd * 64; ntiles = 34;
    }
    const bf16_t* qkvb = p.big + (size_t)b * SEQ * INW;

    bf16x8 qf[2][NKS];
    {
        const bf16_t* q0 = qkvb + (size_t)qt0 * INW + qcol0 + 8 * h;
        const bf16_t* q1 = qkvb + (size_t)qt1 * INW + qcol1 + 8 * h;
#pragma unroll
        for (int kk = 0; kk < NKS; ++kk) {
            qf[0][kk] = *(const bf16x8*)(q0 + ((MODE == MODE_DIFF) ? kk : kk) * 16);
            qf[1][kk] = *(const bf16x8*)(q1 + ((MODE == MODE_DIFF) ? 2 + kk : kk) * 16);
        }
    }
    f32x16 O[2][2];
    float mrun[2], lrun[2];
#pragma unroll
    for (int i = 0; i < 2; ++i) { O[i][0] = zero16(); O[i][1] = zero16(); mrun[i] = NEGF; lrun[i] = 0.f; }

    constexpr int NSLOT = (MODE == MODE_DIL) ? 3 : (MODE == MODE_NA) ? 2 : 1;
    auto tile_info = [&](int t, int& base, int& base1, int& base2, int& stride, int& win, bool& u0, bool& u1, int& sl) {
        base1 = 0; base2 = 0; sl = 0;
        if (MODE == MODE_GQA || MODE == MODE_DIFF) { base = 64 * t; stride = 1; win = 0; u0 = u1 = true; }
        else if (MODE == MODE_NA) {
            const int srel = na_rs - na_rsmin; sl = (t >= srel) ? 0 : 1; const int kr = na_rsmin + t + 8 * sl;
            base = 64 * (na_rsmin + t); base1 = base + 512; stride = 1; win = kr; u0 = u1 = true; }
        else {
            if (t < 10) { base = 512 * dl_c - 64 + 64 * t; stride = 1; win = 64; u0 = u1 = true; }
            else if (t < 18) { const int u = t - 10, tt = u & 3, pi = u >> 2, rc4 = w >> 1;
                base = 512 * dl_c - 256 + 2 * pi + 256 * tt; base1 = base + 1; stride = 4; win = 256; u0 = u1 = ((rc4 >> 1) == pi); sl = rc4 & 1; }
            else { const int v = t - 18;
                   const int q0 = v & 15, q1 = (v + 5) & 15, q2 = (v + 10) & 15;
                   auto cls = [](int q) { const int wq = q >> 1, iq = q & 1; return (wq >> 1) + 4 * (2 * (wq & 1) + iq); };
                   base = 512 * dl_c - 1024 + cls(q0); base1 = 512 * dl_c - 1024 + cls(q1) + 1024; base2 = 512 * dl_c - 1024 + cls(q2) + 2048; stride = 16; win = 1024;
                   const int myq = (w == (q0 >> 1)) ? q0 : (w == (q1 >> 1)) ? q1 : (w == (q2 >> 1)) ? q2 : -1;
                   sl = (myq == q1) ? 1 : (myq == q2) ? 2 : 0;
                   u0 = (myq >= 0) && ((myq & 1) == 0); u1 = (myq >= 0) && ((myq & 1) == 1); }
        }
    };

    const int lrow = tid >> 3, lcp = (tid & 7) * 8;
    u32x4 rk, rv, rk1, rv1, rk2, rv2;
    auto gload = [&](int t) {
        int base, base1, base2, stride, win, sl; bool u0, u1; tile_info(t, base, base1, base2, stride, win, u0, u1, sl);
        const int tok = clampi(base + lrow * stride, 0, SEQ - 1);
        const bf16_t* src = qkvb + (size_t)tok * INW + lcp;
        rk = *(const u32x4*)(src + kcol);
        rv = *(const u32x4*)(src + vcol);
        if constexpr (NSLOT >= 2) {
            if ((MODE == MODE_DIL) ? (t >= 10) : (t + 8 < na_nrows)) {
                const int tok1 = clampi(base1 + lrow * stride, 0, SEQ - 1);
                const bf16_t* src1 = qkvb + (size_t)tok1 * INW + lcp;
                rk1 = *(const u32x4*)(src1 + kcol);
                rv1 = *(const u32x4*)(src1 + vcol);
            }
        }
        if constexpr (NSLOT == 3) {
            if (t >= 18) {
                const int tok2 = clampi(base2 + lrow * stride, 0, SEQ - 1);
                const bf16_t* src2 = qkvb + (size_t)tok2 * INW + lcp;
                rk2 = *(const u32x4*)(src2 + kcol);
                rv2 = *(const u32x4*)(src2 + vcol);
            }
        }
    };
    auto lstore = [&](int t) {
        bf16_t* Kn = KV0 + (t & 1) * (NSLOT * KVBUF);
        *(u32x4*)(Kn + lrow * LDSROW + lcp) = rk;
        *(u32x4*)(Kn + 64 * LDSROW + lrow * VROW + lcp) = rv;
        if constexpr (NSLOT >= 2) {
            if ((MODE == MODE_DIL) ? (t >= 10) : (t + 8 < na_nrows)) {
                *(u32x4*)(Kn + KVBUF + lrow * LDSROW + lcp) = rk1;
                *(u32x4*)(Kn + KVBUF + 64 * LDSROW + lrow * VROW + lcp) = rv1;
            }
        }
        if constexpr (NSLOT == 3) {
            if (t >= 18) {
                *(u32x4*)(Kn + 2 * KVBUF + lrow * LDSROW + lcp) = rk2;
                *(u32x4*)(Kn + 2 * KVBUF + 64 * LDSROW + lrow * VROW + lcp) = rv2;
            }
        }
    };
    gload(0);
    {
        constexpr int W = (MODE == MODE_DIFF) ? 32 : 64;
        const float* qg = (MODE == MODE_GQA) ? p.gq_qn + layer * 64 : (MODE == MODE_DIFF) ? p.df_qn + layer * 32 : (MODE == MODE_NA) ? p.na_qn + layer * 64 : p.dl_qn + layer * 64;
        const float qscale = ((MODE == MODE_DIFF) ? 0.17677669529663687f : 0.125f) * LOG2E;
        const float2* tabs2 = (const float2*)p.tabs;
#pragma unroll
        for (int i = 0; i < 2; ++i) {
            const int pos = (i == 0) ? qt0 : qt1;
            float v[NKS][8];
            float ss = 0.f;
#pragma unroll
            for (int kk = 0; kk < NKS; ++kk) {
                const u32x4 u = __builtin_bit_cast(u32x4, qf[i][kk]);
#pragma unroll
                for (int c = 0; c < 4; ++c) { v[kk][2 * c] = bf2f(u[c] & 0xffffu); v[kk][2 * c + 1] = bf2f(u[c] >> 16); }
#pragma unroll
                for (int j = 0; j < 8; ++j) ss += v[kk][j] * v[kk][j];
            }
            ss = xor32_sum(ss);
            const float rinv = rsqrtf(ss * (1.0f / W) + 1e-6f);
#pragma unroll
            for (int kk = 0; kk < NKS; ++kk)
#pragma unroll
                for (int j = 0; j < 8; ++j) v[kk][j] = v[kk][j] * rinv * qg[16 * kk + 8 * h + j];
            if (MODE == MODE_GQA) {
                const float2* tr = tabs2 + TAB_ROW / 2 + (pos >> 6) * 16 + 8 * h;
                const float2* tc = tabs2 + TAB_COL / 2 + (pos & 63) * 16 + 8 * h;
#pragma unroll
                for (int j = 0; j < 8; ++j) {
                    float2 cs = tr[j]; float a = v[0][j], b = v[1][j];
                    v[0][j] = a * cs.x - b * cs.y; v[1][j] = a * cs.y + b * cs.x;
                    cs = tc[j]; a = v[2][j]; b = v[3][j];
                    v[2][j] = a * cs.x - b * cs.y; v[3][j] = a * cs.y + b * cs.x;
                }
            }
            if (MODE == MODE_DIL) {
                const float2* td = tabs2 + TAB_DIL / 2 + pos * 8;
#pragma unroll
                for (int j = 0; j < 8; ++j) {
                    const float mine = v[0][j];
                    const auto r = __builtin_amdgcn_permlane32_swap(__float_as_uint(mine), __float_as_uint(mine), false, false);
                    const float x1 = __uint_as_float(r[0]), x2 = __uint_as_float(r[1]);
                    const float2 cs = td[j];
                    v[0][j] = (h == 0) ? (x1 * cs.x - x2 * cs.y) : (x1 * cs.y + x2 * cs.x);
                }
            }
            if (MODE == MODE_DIFF) {
                const float2* tf = tabs2 + TAB_DIFF / 2 + pos * 4;
#pragma unroll
                for (int j = 0; j < 4; ++j) {
                    const float2 cs = tf[j]; const float a = v[0][j], b = v[0][j + 4];
                    const float ra = a * cs.x - b * cs.y, rb = a * cs.y + b * cs.x;
                    v[0][j] = (h == 0) ? ra : a; v[0][j + 4] = (h == 0) ? rb : b;
                }
            }
#pragma unroll
            for (int kk = 0; kk < NKS; ++kk) {
                u32x4 u;
#pragma unroll
                for (int c = 0; c < 4; ++c) u[c] = pack2(v[kk][2 * c] * qscale, v[kk][2 * c + 1] * qscale);
                qf[i][kk] = __builtin_bit_cast(bf16x8, u);
            }
        }
    }

    __syncthreads();
    lstore(0);
    constexpr bool LAZYLOAD = false;
    if (!LAZYLOAD && ntiles > 1) gload(1);
    __syncthreads();
#pragma unroll 1
    for (int t = 0; t < ntiles; ++t) {
        int base, base1, base2, stride, win, sl; bool use[2];
        tile_info(t, base, base1, base2, stride, win, use[0], use[1], sl);
        if (sl == 1) base = base1; else if (sl == 2) base = base2;
        bf16_t* Ks = KV0 + (t & 1) * (NSLOT * KVBUF) + sl * KVBUF;
        bf16_t* Vs = Ks + 64 * LDSROW;
        if (!LAZYLOAD && t + 1 < ntiles) {
            lstore(t + 1);
            if (t + 2 < ntiles) gload(t + 2);
        }
        if (use[0] || use[1]) {

        bf16x8 pf[2][2][2];
#pragma unroll
        for (int i = 0; i < 2; ++i) {
            if (use[i]) {
                const int tq = (i == 0) ? qt0 : qt1;
                f32x16 Sx[2];
#pragma unroll
                for (int sub = 0; sub < 2; ++sub) {
                    f32x16 sacc = zero16();
#pragma unroll
                    for (int kk = 0; kk < NKS; ++kk) {
                        const bf16x8 kf = *(const bf16x8*)(Ks + (sub * 32 + n) * LDSROW + ((MODE == MODE_DIFF) ? 2 * i + kk : kk) * 16 + 8 * h);
                        sacc = MFMA32(kf, qf[i][kk], sacc);
                    }
                    Sx[sub] = sacc;
                }
                if (MODE == MODE_NA) {
                    const int c = tq & 63, cs = clampi(c - 8, 0, 48), kr = win;
                    const int rowoff = (kr - na_r + 7) * 31;
#pragma unroll
                    for (int sub = 0; sub < 2; ++sub)
#pragma unroll
                        for (int j = 0; j < 16; ++j) {
                            const int kc = sub * 32 + (j & 3) + 8 * (j >> 2) + 4 * h;
                            const bool valid = (unsigned)(kc - cs) < 16u;
                            const int bi = valid ? rowoff + (kc - c + 15) : 0;
                            const float bv = biasS[bi];
                            Sx[sub][j] = valid ? Sx[sub][j] + bv : NEGF;
                        }
                }
                if (MODE == MODE_DIL) {
                    const int sh = (stride == 1) ? 0 : ((stride == 4) ? 2 : 4);
                    const int tlo = (tq - win < 0) ? 0 : tq - win, thi = (tq + win > SEQ - 1) ? SEQ - 1 : tq + win;
                    const int klo = ((tlo - base + stride - 1) >> sh) - 4 * h, khi = ((thi - base) >> sh) - 4 * h;
#pragma unroll
                    for (int sub = 0; sub < 2; ++sub)
#pragma unroll
                        for (int j = 0; j < 16; ++j) {
                            const int cj = sub * 32 + (j & 3) + 8 * (j >> 2);
                            const bool valid = (klo <= cj) && (cj <= khi);
                            Sx[sub][j] = valid ? Sx[sub][j] : NEGF;
                        }
                }
                if constexpr (FAST) {
                    float rs0 = 0.f;
#pragma unroll
                    for (int sub = 0; sub < 2; ++sub)
#pragma unroll
                        for (int j = 0; j < 16; j += 4) {
                            const float p0 = __builtin_amdgcn_exp2f(Sx[sub][j]), p1 = __builtin_amdgcn_exp2f(Sx[sub][j + 1]);
                            const float p2 = __builtin_amdgcn_exp2f(Sx[sub][j + 2]), p3 = __builtin_amdgcn_exp2f(Sx[sub][j + 3]);
                            Sx[sub][j] = p0; Sx[sub][j + 1] = p1; Sx[sub][j + 2] = p2; Sx[sub][j + 3] = p3;
                            rs0 = (((rs0 + p0) + p1) + p2) + p3;
                        }
                    lrun[i] += rs0;
                } else {
                float mx;
                {
                    float m4[4];
#pragma unroll
                    for (int q = 0; q < 4; ++q) {
                        float a = fmaxf(fmaxf(Sx[0][4 * q], Sx[0][4 * q + 1]), Sx[0][4 * q + 2]);
                        a = fmaxf(fmaxf(a, Sx[0][4 * q + 3]), Sx[1][4 * q]);
                        a = fmaxf(fmaxf(a, Sx[1][4 * q + 1]), Sx[1][4 * q + 2]);
                        m4[q] = fmaxf(a, Sx[1][4 * q + 3]);
                    }
                    mx = fmaxf(fmaxf(m4[0], m4[1]), fmaxf(m4[2], m4[3]));
                }
                mx = xor32_max(mx);
                const float mnew = (mx > mrun[i] + 8.0f) ? mx : mrun[i];
                const float alpha = __builtin_amdgcn_exp2f(mrun[i] - mnew);
                mrun[i] = mnew;
                float rs0 = 0.f;
#pragma unroll
                for (int sub = 0; sub < 2; ++sub)
#pragma unroll
                    for (int j = 0; j < 16; j += 4) {
                        const float p0 = __builtin_amdgcn_exp2f(fsub_s(Sx[sub][j], mnew)), p1 = __builtin_amdgcn_exp2f(fsub_s(Sx[sub][j + 1], mnew));
                        const float p2 = __builtin_amdgcn_exp2f(fsub_s(Sx[sub][j + 2], mnew)), p3 = __builtin_amdgcn_exp2f(fsub_s(Sx[sub][j + 3], mnew));
                        Sx[sub][j] = p0; Sx[sub][j + 1] = p1; Sx[sub][j + 2] = p2; Sx[sub][j + 3] = p3;
                        rs0 = (((rs0 + p0) + p1) + p2) + p3;
                    }
                lrun[i] = lrun[i] * alpha + rs0;
                if (__any(alpha != 1.0f)) {
#pragma unroll
                    for (int dt = 0; dt < 2; ++dt)
#pragma unroll
                        for (int j = 0; j < 16; ++j) O[i][dt][j] *= alpha;
                }
                }
#pragma unroll
                for (int sub = 0; sub < 2; ++sub)
#pragma unroll
                    for (int s = 0; s < 2; ++s) {
                        u32x4 u;
                        u.x = pack2(Sx[sub][8 * s + 0], Sx[sub][8 * s + 1]); u.y = pack2(Sx[sub][8 * s + 2], Sx[sub][8 * s + 3]);
                        u.z = pack2(Sx[sub][8 * s + 4], Sx[sub][8 * s + 5]); u.w = pack2(Sx[sub][8 * s + 6], Sx[sub][8 * s + 7]);
                        pf[i][sub][s] = __builtin_bit_cast(bf16x8, u);
                    }
            } else {
#pragma unroll
                for (int sub = 0; sub < 2; ++sub)
#pragma unroll
                    for (int s = 0; s < 2; ++s) pf[i][sub][s] = (bf16x8){0, 0, 0, 0, 0, 0, 0, 0};
            }
        }
        {
            const int blk = (lane >> 4) & 1, q4 = (lane & 15) >> 2, p4 = lane & 3;
            const bf16_t* vbase = Vs + (4 * h + q4) * VROW + 16 * blk + 4 * p4;
#pragma unroll
            for (int sub = 0; sub < 2; ++sub)
#pragma unroll
                for (int s = 0; s < 2; ++s) {
                    bf16x8 vf[2];
#pragma unroll
                    for (int dt = 0; dt < 2; ++dt) {
                        const bf16_t* a = vbase + (sub * 32 + 16 * s) * VROW + dt * 32;
                        const s16x4 lo = __builtin_amdgcn_ds_read_tr16_b64_v4i16((LDS3 s16x4*)(a));
                        const s16x4 hi = __builtin_amdgcn_ds_read_tr16_b64_v4i16((LDS3 s16x4*)(a + 8 * VROW));
                        vf[dt] = __builtin_shufflevector(lo, hi, 0, 1, 2, 3, 4, 5, 6, 7);
                    }
#pragma unroll
                    for (int i = 0; i < 2; ++i)
                        if (use[i]) {
#pragma unroll
                            for (int dt = 0; dt < 2; ++dt) O[i][dt] = MFMA32(vf[dt], pf[i][sub][s], O[i][dt]);
                        }
                }
        }
        }
        if (LAZYLOAD && t + 1 < ntiles) { gload(t + 1); lstore(t + 1); }
        __syncthreads();
    }

    float inv[2];
#pragma unroll
    for (int i = 0; i < 2; ++i) { const float lt = xor32_sum(lrun[i]); inv[i] = 1.0f / lt; }
    bf16_t* ob = p.o + (size_t)b * SEQ * DM;
    if (MODE == MODE_DIFF) {
        const float lam = p.tabs[TAB_LAM + layer];
        const float lambda_init = 0.8f - 0.6f * expf(-0.3f * (float)layer);
        float ss = 0.f;
#pragma unroll
        for (int dt = 0; dt < 2; ++dt)
#pragma unroll
            for (int j = 0; j < 16; ++j) { const float v = O[0][dt][j] * inv[0] - lam * (O[1][dt][j] * inv[1]); O[0][dt][j] = v; ss += v * v; }
        ss = xor32_sum(ss);
        const float rinv = rsqrtf(ss * (1.0f / 64.0f) + 1e-6f) * (1.0f - lambda_init);
        const float* og = p.df_on + layer * 64;
        bf16_t* o = ob + (size_t)qt0 * DM + ocol0 + 4 * h;
#pragma unroll
        for (int dt = 0; dt < 2; ++dt)
#pragma unroll
            for (int g = 0; g < 4; ++g) {
                const float4 gg = *(const float4*)(og + dt * 32 + 8 * g + 4 * h);
                u32x2 pk;
                pk.x = pack2(O[0][dt][4 * g] * rinv * gg.x, O[0][dt][4 * g + 1] * rinv * gg.y);
                pk.y = pack2(O[0][dt][4 * g + 2] * rinv * gg.z, O[0][dt][4 * g + 3] * rinv * gg.w);
                *(u32x2*)(o + dt * 32 + 8 * g) = pk;
            }
    } else {
#pragma unroll
        for (int i = 0; i < 2; ++i) {
            bf16_t* o = ob + (size_t)((i == 0) ? qt0 : qt1) * DM + ((i == 0) ? ocol0 : ocol1) + 4 * h;
#pragma unroll
            for (int dt = 0; dt < 2; ++dt)
#pragma unroll
                for (int g = 0; g < 4; ++g) {
                    u32x2 pk;
                    pk.x = pack2(O[i][dt][4 * g] * inv[i], O[i][dt][4 * g + 1] * inv[i]);
                    pk.y = pack2(O[i][dt][4 * g + 2] * inv[i], O[i][dt][4 * g + 3] * inv[i]);
                    *(u32x2*)(o + dt * 32 + 8 * g) = pk;
                }
        }
    }
}

__device__ void phase_attn(const Params& p, int layer, char* smem, int wv) {
    constexpr int N_DIFF = 512, N_GQA = 256, N_NA = 256, N_DIL = 256;
    const int bid = __builtin_amdgcn_readfirstlane((int)blockIdx.x), G = __builtin_amdgcn_readfirstlane((int)gridDim.x);
    const bool fast_gqa = __builtin_amdgcn_readfirstlane((int)(p.tabs[TAB_BND + 4 * layer] <= 60.0f)) != 0;
    const bool fast_diff = __builtin_amdgcn_readfirstlane((int)(p.tabs[TAB_BND + 4 * layer + 1] <= 60.0f)) != 0;
    const bool fast_dil = __builtin_amdgcn_readfirstlane((int)(p.tabs[TAB_BND + 4 * layer + 3] <= 60.0f)) != 0;
    const bool xmap = (G == 256);
    const int xcd = bid & 7, idx = bid >> 3;
    for (int k = 0; k * G + bid < N_DIFF; ++k) {
        const int it = xmap ? ((2 * xcd + k) * 32 + idx) : (k * G + bid);
        if (fast_diff) attn_item<MODE_DIFF, true>(p, layer, it, smem, wv); else attn_item<MODE_DIFF, false>(p, layer, it, smem, wv);
    }
    for (int k = 0; k * G + bid < N_GQA; ++k) {
        const int it = xmap ? (xcd * 32 + idx) : (k * G + bid);
        if (fast_gqa) attn_item<MODE_GQA, true>(p, layer, it, smem, wv); else attn_item<MODE_GQA, false>(p, layer, it, smem, wv);
    }
    for (int k = 0; k * G + bid < N_NA; ++k) {
        const int it = xmap ? ((2 * xcd + (idx >> 4)) * 16 + (idx & 15)) : (k * G + bid);
        attn_item<MODE_NA, false>(p, layer, it, smem, wv);
    }
    for (int k = 0; k * G + bid < N_DIL; ++k) {
        const int it = xmap ? ((2 * xcd + (idx >> 4)) * 16 + (idx & 15)) : (k * G + bid);
        if (fast_dil) attn_item<MODE_DIL, true>(p, layer, it, smem, wv); else attn_item<MODE_DIL, false>(p, layer, it, smem, wv);
    }
}

#define LAS __attribute__((address_space(3)))
#define XB_TMO      128
#define XB_XCNT(j)  (256  + 64 * (j))
#define XB_XSUB(j)  (1280 + 64 * (j))
#define XB_XGEN(j)  (2304 + 64 * (j))
#define XB_TOP      3328
#define XB_TOPGEN   3392
#define XCD_BAR_WORDS 3456
#define XB_SPIN_CAP (1u << 18)

__device__ __forceinline__ unsigned xb_ld(unsigned* p)              { return __hip_atomic_load(p, __ATOMIC_RELAXED, __HIP_MEMORY_SCOPE_AGENT); }
__device__ __forceinline__ unsigned xb_add(unsigned* p, unsigned v) { return __hip_atomic_fetch_add(p, v, __ATOMIC_RELAXED, __HIP_MEMORY_SCOPE_AGENT); }
__device__ __forceinline__ unsigned xb_xcc_id() { return (unsigned)__builtin_amdgcn_s_getreg((3 << 11) | 20) & 0xFu; }
#define XB_SPIN(cond, bar) do { unsigned _sp = 0; while (cond) { __builtin_amdgcn_s_sleep(1); \
    if ((++_sp & 255u) == 0u) { if (xb_ld(&(bar)[XB_TMO])) break; if (_sp > XB_SPIN_CAP) { atomicAdd(&(bar)[XB_TMO], 1u); break; } } } } while (0)

struct XcdBarrier {
    unsigned* bar; unsigned x; int wv;
    volatile LAS unsigned* st;
};

__device__ __forceinline__ XcdBarrier xcd_barrier_post(unsigned* bar, volatile LAS unsigned* st) {
    XcdBarrier b; b.bar = bar; b.x = xb_xcc_id(); b.st = st; b.wv = __builtin_amdgcn_readfirstlane((int)(threadIdx.x >> 6));
    if (threadIdx.x == 0) (void)xb_add(&bar[XB_XCNT(b.x)], 1u);
    return b;
}
__device__ __forceinline__ void xcd_barrier_complete(unsigned* bar, unsigned x, unsigned& nloc, unsigned& nx) {
    const unsigned G = gridDim.x * gridDim.y * gridDim.z;
    unsigned sum, cnt, mine, sp = 0u;
    for (;;) {
        sum = 0u; cnt = 0u; mine = 0u;
#pragma unroll
        for (unsigned j = 0; j < 16; ++j) { const unsigned c = xb_ld(&bar[XB_XCNT(j)]); sum += c; cnt += (c > 0u) ? 1u : 0u; mine = (j == x) ? c : mine; }
        if (sum == G) break;
        __builtin_amdgcn_s_sleep(1);
        if ((++sp & 255u) == 0u) { if (xb_ld(&bar[XB_TMO])) break; if (sp > XB_SPIN_CAP) { atomicAdd(&bar[XB_TMO], 1u); break; } }
    }
    nloc = mine > 0u ? mine : 1u; nx = cnt > 0u ? cnt : 1u;
}

__device__ __forceinline__ void xcd_barrier(const XcdBarrier& b) {
    asm volatile("s_waitcnt vmcnt(0)" ::: "memory");
    __syncthreads();
    if (b.wv == 0 && lane_id() == 0) {
        unsigned* bar = b.bar;
        __builtin_amdgcn_s_waitcnt(0);
        unsigned nloc = b.st[0], nx = b.st[1];
        if (nloc == 0u) { xcd_barrier_complete(bar, b.x, nloc, nx); b.st[0] = nloc; b.st[1] = nx; }
        const unsigned old = xb_add(&bar[XB_XSUB(b.x)], 1u);
        const unsigned gen = old / nloc;
        if (old + 1u == (gen + 1u) * nloc) {
            __builtin_amdgcn_fence(__ATOMIC_RELEASE, "agent");
            asm volatile("s_waitcnt vmcnt(0)" ::: "memory");
            const unsigned og = xb_add(&bar[XB_TOP], 1u);
            const unsigned tg = og / nx;
            if (og + 1u == (tg + 1u) * nx) xb_add(&bar[XB_TOPGEN], 1u);
            else XB_SPIN(xb_ld(&bar[XB_TOPGEN]) == tg, bar);
            __builtin_amdgcn_fence(__ATOMIC_ACQUIRE, "agent");
            xb_add(&bar[XB_XGEN(b.x)], 1u);
            asm volatile("s_waitcnt vmcnt(0)" ::: "memory");
        } else {
            XB_SPIN(xb_ld(&bar[XB_XGEN(b.x)]) == gen, bar);
            __builtin_amdgcn_fence(__ATOMIC_ACQUIRE, "agent");
            asm volatile("s_waitcnt vmcnt(0)" ::: "memory");
        }
    }
    __syncthreads();
}

constexpr int LDS_BYTES = 131072 + 11 * 256 * 4 + 16;
constexpr int XB_LDS_OFF = 131072 + 11 * 256 * 4;

__global__ void __launch_bounds__(512, 2) fwd_megakernel(Params p) {
    extern __shared__ __attribute__((aligned(16))) unsigned char lds[];
    char* smem = (char*)lds;
    cg::grid_group grid = cg::this_grid();
    if (threadIdx.x < 4) ((volatile LAS unsigned*)(lds + XB_LDS_OFF))[threadIdx.x] = 0u;
    __syncthreads();
    const XcdBarrier xb = xcd_barrier_post(p.bar, (volatile LAS unsigned*)(lds + XB_LDS_OFF));
    const int wv = xb.wv;
    phase_wprep(p, smem, wv);
    phase_init_x(p.x, p.out, p.h, p.ss, wv);
    if (p.bar == nullptr) grid.sync();
    xcd_barrier(xb);
    for (int l = 0; l < NLAYER; ++l) {
        const bf16_t* wl = p.wb + (size_t)l * W_LAYER;
        float* ss0 = p.ss + (size_t)(3 * l) * T_TOK * 16; float* ss1 = ss0 + T_TOK * 16; float* ss2 = ss1 + T_TOK * 16; float* ss3 = ss2 + T_TOK * 16;
        run_gemm(lds, p.h, wl + W_GU1, 2 * DFF, DM, pg8::EpiSwiglu{p.big, DFF, ss0, nullptr}, wv);
        xcd_barrier(xb);
        if (l == 0) run_gemm(lds, p.big, wl + W_D1, DM, DFF, pg8::EpiResid<true, false>{p.x, nullptr, DM, 0.5f, p.h, p.xl, ss1}, wv);
        else        run_gemm(lds, p.big, wl + W_D1, DM, DFF, pg8::EpiResid<false, false>{nullptr, nullptr, DM, 0.5f, p.h, p.xl, ss1}, wv);
        xcd_barrier(xb);
        run_gemm(lds, p.h, wl + W_IN, INW, DM, pg8::EpiQkv{p.big, INW, ss1, nullptr}, wv);
        xcd_barrier(xb);
        phase_prep(p, l, wv);
        xcd_barrier(xb);
        phase_attn(p, l, smem, wv);
        xcd_barrier(xb);
        run_gemm(lds, p.o, wl + W_OUT, DM, DM, pg8::EpiResid<false, false>{nullptr, nullptr, DM, 1.0f, p.h, p.xl, ss2}, wv);
        xcd_barrier(xb);
        run_gemm(lds, p.h, wl + W_GU2, 2 * DFF, DM, pg8::EpiSwiglu{p.big, DFF, ss2, nullptr}, wv);
        xcd_barrier(xb);
        if (l + 1 < NLAYER) run_gemm(lds, p.big, wl + W_D2, DM, DFF, pg8::EpiResid<false, false>{nullptr, nullptr, DM, 0.5f, p.h, p.xl, ss3}, wv);
        else                run_gemm(lds, p.big, wl + W_D2, DM, DFF, pg8::EpiResid<false, true>{nullptr, p.out, DM, 0.5f, p.h, p.xl, ss3}, wv);
        if (l + 1 < NLAYER) xcd_barrier(xb);
    }
}

extern "C" void kernel_launch(void* const* d_in, const int* in_sizes, int n_in, void* d_out, int out_size, void* d_ws, size_t ws_size, hipStream_t stream) {
    static int grid_blocks = 0;
    if (!grid_blocks) {
        int dev = 0, cus = 0, per_cu = 0;
        (void)hipGetDevice(&dev);
        (void)hipDeviceGetAttribute(&cus, hipDeviceAttributeMultiprocessorCount, dev);
        if (hipFuncSetAttribute((const void*)fwd_megakernel, hipFuncAttributeMaxDynamicSharedMemorySize, LDS_BYTES) != hipSuccess) fprintf(stderr, "hipFuncSetAttribute failed\n");
        (void)hipOccupancyMaxActiveBlocksPerMultiprocessor(&per_cu, (const void*)fwd_megakernel, 512, LDS_BYTES);
        if (per_cu < 1) fprintf(stderr, "occupancy query reports %d blocks per CU\n", per_cu);
        (void)hipGetLastError();
        grid_blocks = cus;
    }
    Params p{};
    p.x = (const float*)d_in[0];
    p.ffn1_norm = (const float*)d_in[1]; p.ffn1_wg = (const float*)d_in[2]; p.ffn1_wu = (const float*)d_in[3]; p.ffn1_wd = (const float*)d_in[4];
    p.mix_norm = (const float*)d_in[5]; p.w_in = (const float*)d_in[6]; p.w_out = (const float*)d_in[7];
    p.na_qn = (const float*)d_in[8]; p.na_kn = (const float*)d_in[9]; p.na_bias = (const float*)d_in[10];
    p.df_qn = (const float*)d_in[11]; p.df_kn = (const float*)d_in[12];
    p.lq1 = (const float*)d_in[13]; p.lk1 = (const float*)d_in[14]; p.lq2 = (const float*)d_in[15]; p.lk2 = (const float*)d_in[16];
    p.df_on = (const float*)d_in[17]; p.gq_qn = (const float*)d_in[18]; p.gq_kn = (const float*)d_in[19];
    p.dl_qn = (const float*)d_in[20]; p.dl_kn = (const float*)d_in[21];
    p.ffn2_norm = (const float*)d_in[22]; p.ffn2_wg = (const float*)d_in[23]; p.ffn2_wu = (const float*)d_in[24]; p.ffn2_wd = (const float*)d_in[25];
    p.out = (float*)d_out;
    char* ws = (char*)d_ws;
    size_t off = 0;
    p.wb = (bf16_t*)(ws + off); off += (size_t)W_LAYER * NLAYER * 2;
    p.h = (bf16_t*)(ws + off); off += (size_t)T_TOK * DM * 2;
    p.o = (bf16_t*)d_out;
    p.xl = (unsigned char*)(ws + off); off += (size_t)T_TOK * DM;
    p.ss = (float*)(ws + off); off += (size_t)13 * T_TOK * 16 * 4;
    p.big = (bf16_t*)(ws + off); off += (size_t)T_TOK * INW * 2;
    p.tabs = (float*)(ws + off); off += (size_t)TAB_TOTAL * 4;
    off = (off + 255) & ~(size_t)255;
    p.bar = (unsigned*)(ws + off); off += (size_t)XCD_BAR_WORDS * 4;
    if (off > ws_size) { fprintf(stderr, "workspace too small: need %zu have %zu\n", off, ws_size); return; }
    if (hipMemsetAsync(p.bar, 0, (size_t)XCD_BAR_WORDS * 4, stream) != hipSuccess) { fprintf(stderr, "memset of barrier words failed\n"); return; }
    void* args[] = {&p};
    hipError_t e = hipLaunchCooperativeKernel((void*)fwd_megakernel, dim3(grid_blocks), dim3(512), args, LDS_BYTES, stream);
    if (e != hipSuccess) fprintf(stderr, "cooperative launch failed: %s (grid %d)\n", hipGetErrorString(e), grid_blocks);
}
```
